# Optimizing an MI355X kernel written in HIP

```python
import math
import jax, jax.numpy as jnp
from jax import lax
import numpy as np

D_MODEL = 1024
BATCH = 8
SEQ = 4096
DEPTH = 1

EPS = 1e-6
GLA_HEADS = 4
GLA_DK = D_MODEL // (2 * GLA_HEADS)
GLA_DV = D_MODEL // GLA_HEADS
GLA_KEY = GLA_HEADS * GLA_DK
GLA_VAL = GLA_HEADS * GLA_DV
GLA_RANK = 16
GLA_GATE_TEMP = 16.0
GLA_CHUNK = 64
HY_WIDTH = D_MODEL
HY_BANDS = 16
HY_EMB = 1 + 2 * HY_BANDS
HY_FFN = 64
HY_TARGET = 1e-2
HY_FAST_PCT = 0.3
HY_SLOW_PCT = 1.5
N_EXPERTS = 32
TOP_K = 4
D_FF = D_MODEL
SWIGLU_LIMIT = 7.0
SWIGLU_ALPHA = 1.702
IN_SIZES = (GLA_KEY, GLA_KEY, GLA_VAL, GLA_VAL, 2 * GLA_RANK, 3 * HY_WIDTH, 2 * D_MODEL)
IN_TOTAL = sum(IN_SIZES)
IN_SPLITS = tuple(int(v) for v in np.cumsum(IN_SIZES)[:-1])

kernel_name = "hybrid_gla_hyena_moe_encoder"


def rms_norm(x, w):
    xf = x.astype(jnp.float32)
    y = xf * lax.rsqrt(jnp.mean(xf * xf, axis=-1, keepdims=True) + EPS)
    return (y * w.astype(jnp.float32)).astype(x.dtype)


def gla_one_direction(q, k, v, g, strict):
    B, L, _ = q.shape
    N = L // GLA_CHUNK

    def chunks(t, d):
        return t.reshape(B, N, GLA_CHUNK, GLA_HEADS, d).transpose(0, 3, 1, 2, 4)

    qc, kc, gc, vc = chunks(q, GLA_DK), chunks(k, GLA_DK), chunks(g, GLA_DK), chunks(v, GLA_DV)
    b = jnp.cumsum(gc, axis=-2)
    b_last = b[..., -1:, :]
    q_t = qc * jnp.exp(b)
    k_t = kc * jnp.exp(-b)
    idx = jnp.arange(GLA_CHUNK)
    mask = (idx[:, None] > idx[None, :]) if strict else (idx[:, None] >= idx[None, :])
    scores = jnp.einsum('bhncd,bhnsd->bhncs', q_t, k_t)
    scores = jnp.where(mask, scores, 0.0)
    o_intra = jnp.einsum('bhncs,bhnse->bhnce', scores, vc)
    k_end = kc * jnp.exp(b_last - b)
    upd = jnp.einsum('bhncd,bhnce->bhnde', k_end, vc)
    dec = jnp.exp(b_last[..., 0, :])

    def step(state, inp):
        d_n, u_n = inp
        return d_n[..., None] * state + u_n, state

    init = jnp.zeros((B, GLA_HEADS, GLA_DK, GLA_DV), jnp.float32)
    _, s_prev = lax.scan(step, init, (jnp.moveaxis(dec, 2, 0), jnp.moveaxis(upd, 2, 0)))
    s_prev = jnp.moveaxis(s_prev, 0, 2)
    o_inter = jnp.einsum('bhncd,bhnde->bhnce', q_t, s_prev)
    o = o_intra + o_inter
    return o.transpose(0, 2, 3, 1, 4).reshape(B, L, GLA_HEADS, GLA_DV)


def gla_branch(q, k, v, r, a_low, gla_gate_w2, gla_gate_b, gla_norm_w):
    dt = q.dtype
    B, L, _ = q.shape
    qf = q.astype(jnp.float32) * (GLA_DK ** -0.5)
    kf = k.astype(jnp.float32)
    vf = v.astype(jnp.float32)
    a2 = a_low.astype(jnp.float32).reshape(B, L, 2, GLA_RANK)
    logits = jnp.einsum('bldr,drk->bldk', a2, gla_gate_w2.astype(jnp.float32)) + gla_gate_b.astype(jnp.float32)
    log_a = jax.nn.log_sigmoid(logits) / GLA_GATE_TEMP
    o_f = gla_one_direction(qf, kf, vf, log_a[:, :, 0], strict=False)
    flip = lambda t: jnp.flip(t, axis=1)
    o_b = flip(gla_one_direction(flip(qf), flip(kf), flip(vf), flip(log_a[:, :, 1]), strict=True))
    o = o_f + o_b
    o = o * lax.rsqrt(jnp.mean(o * o, axis=-1, keepdims=True) + EPS) * gla_norm_w.astype(jnp.float32)
    o = o.reshape(B, L, GLA_VAL).astype(dt)
    return o * jax.nn.silu(r)


def short_conv3(u, w, b):
    up = jnp.pad(u, ((0, 0), (1, 1), (0, 0)))
    return w[0] * up[:, :-2] + w[1] * up[:, 1:-1] + w[2] * up[:, 2:] + b


def hyena_filters(L, hy_freq, w1, b1, w2, b2, w3, hy_decay):
    f32 = jnp.float32
    t = jnp.linspace(0.0, 1.0, L, dtype=f32)[:, None]
    omega = 2.0 * math.pi * jnp.arange(L, dtype=f32) / L
    f = jnp.linspace(1e-4, HY_BANDS - 1, HY_BANDS, dtype=f32)
    ang = omega[:, None] * f[None, :]
    z = jnp.concatenate([t, jnp.cos(ang), -jnp.sin(ang)], axis=-1)
    fr = hy_freq.astype(f32)
    h = jnp.sin(fr * (z @ w1.astype(f32) + b1.astype(f32)))
    h = jnp.sin(fr * (h @ w2.astype(f32) + b2.astype(f32)))
    h = (h @ w3.astype(f32)).reshape(L, 2, HY_WIDTH)
    h = h * jnp.exp(-t[:, :, None] * jnp.abs(hy_decay.astype(f32))[None])
    kern = jnp.concatenate([h[:, 0], jnp.zeros((1, HY_WIDTH), f32), h[:0:-1, 1]], axis=0)
    return kern * lax.rsqrt(jnp.sum(kern * kern, axis=0, keepdims=True) + EPS)


def hyena_branch(u_proj, conv_w, conv_b, kern, hy_bias):
    dt = u_proj.dtype
    u = short_conv3(u_proj, conv_w, conv_b)
    x0, x1, v = jnp.split(u, 3, axis=-1)
    z = (v * x1).astype(jnp.float32)
    L = z.shape[1]
    Z = jnp.fft.rfft(z, n=2 * L, axis=1)
    K = jnp.fft.rfft(kern, n=2 * L, axis=0)
    y = jnp.fft.irfft(Z * K[None], n=2 * L, axis=1)[:, :L] + z * hy_bias.astype(jnp.float32)
    return y.astype(dt) * x0


def moe_ffn(h, router_w, router_b, w_gate_up, b_gate_up, w_down, b_down):
    B, L, D = h.shape
    ht = h.reshape(B * L, D)
    logits = ht.astype(jnp.float32) @ router_w.astype(jnp.float32) + router_b.astype(jnp.float32)
    top_vals, top_idx = lax.top_k(logits, TOP_K)
    weights = jax.nn.softmax(top_vals, axis=-1)
    combine = jnp.sum(jax.nn.one_hot(top_idx, N_EXPERTS, dtype=jnp.float32) * weights[..., None], axis=1)
    combine = combine.astype(ht.dtype)
    out = jnp.zeros_like(ht)
    for e in range(N_EXPERTS):
        gu = ht @ w_gate_up[e] + b_gate_up[e]
        gate, up = gu[:, :D_FF], gu[:, D_FF:]
        gate = jnp.minimum(gate, SWIGLU_LIMIT)
        up = jnp.clip(up, -SWIGLU_LIMIT, SWIGLU_LIMIT)
        act = gate * jax.nn.sigmoid(SWIGLU_ALPHA * gate) * (up + 1.0)
        out = out + combine[:, e:e + 1] * (act @ w_down[e] + b_down[e])
    return out.reshape(B, L, D)


def setup_inputs(seed: int = 0) -> dict:
    key = jax.random.key(seed)
    ks = jax.random.split(key, 32)
    f32 = jnp.float32
    nrm = lambda k, shape, s: jax.random.normal(k, shape, f32) * s
    min_decay = abs(math.log(HY_TARGET) / HY_SLOW_PCT)
    max_decay = abs(math.log(HY_TARGET) / HY_FAST_PCT)
    base_decay = jnp.linspace(min_decay, max_decay, HY_WIDTH, dtype=f32)
    return {
        "x": nrm(ks[0], (BATCH, SEQ, D_MODEL), 1.0),
        "norm1_w": 1.0 + nrm(ks[1], (D_MODEL,), 0.02),
        "w_in": nrm(ks[2], (D_MODEL, IN_TOTAL), D_MODEL ** -0.5),
        "gla_gate_w2": nrm(ks[3], (2, GLA_RANK, GLA_KEY), GLA_RANK ** -0.5),
        "gla_gate_b": nrm(ks[4], (2, GLA_KEY), 0.5),
        "gla_norm_w": 1.0 + nrm(ks[5], (GLA_DV,), 0.02),
        "hy_conv_w": nrm(ks[6], (3, 3 * HY_WIDTH), 0.5),
        "hy_conv_b": nrm(ks[7], (3 * HY_WIDTH,), 0.02),
        "hy_freq": 1.0 + nrm(ks[8], (HY_FFN,), 0.05),
        "hy_ffn_w1": nrm(ks[9], (HY_EMB, HY_FFN), HY_EMB ** -0.5),
        "hy_ffn_b1": nrm(ks[10], (HY_FFN,), 0.1),
        "hy_ffn_w2": nrm(ks[11], (HY_FFN, HY_FFN), HY_FFN ** -0.5),
        "hy_ffn_b2": nrm(ks[12], (HY_FFN,), 0.1),
        "hy_ffn_w3": nrm(ks[13], (HY_FFN, 2 * HY_WIDTH), HY_FFN ** -0.5),
        "hy_decay": base_decay[None, :] * (1.0 + nrm(ks[14], (2, HY_WIDTH), 0.05)),
        "hy_bias": nrm(ks[15], (HY_WIDTH,), 0.1),
        "w_branch_gla": nrm(ks[16], (GLA_VAL, D_MODEL), GLA_VAL ** -0.5),
        "w_branch_hy": nrm(ks[17], (HY_WIDTH, D_MODEL), HY_WIDTH ** -0.5),
        "w_out": nrm(ks[18], (D_MODEL, D_MODEL), D_MODEL ** -0.5),
        "norm2_w": 1.0 + nrm(ks[19], (D_MODEL,), 0.02),
        "router_w": nrm(ks[20], (D_MODEL, N_EXPERTS), D_MODEL ** -0.5),
        "router_b": nrm(ks[21], (N_EXPERTS,), 0.01),
        "w_gate_up": nrm(ks[22], (N_EXPERTS, D_MODEL, 2 * D_FF), D_MODEL ** -0.5),
        "b_gate_up": nrm(ks[23], (N_EXPERTS, 2 * D_FF), 0.01),
        "w_down": nrm(ks[24], (N_EXPERTS, D_FF, D_MODEL), D_FF ** -0.5),
        "b_down": nrm(ks[25], (N_EXPERTS, D_MODEL), 0.01),
        "norm_f_w": 1.0 + nrm(ks[26], (D_MODEL,), 0.02),
    }


def reference(x, norm1_w, w_in, gla_gate_w2, gla_gate_b, gla_norm_w, hy_conv_w, hy_conv_b,
              hy_freq, hy_ffn_w1, hy_ffn_b1, hy_ffn_w2, hy_ffn_b2, hy_ffn_w3, hy_decay, hy_bias,
              w_branch_gla, w_branch_hy, w_out, norm2_w, router_w, router_b,
              w_gate_up, b_gate_up, w_down, b_down, norm_f_w):
    h = x
    L = x.shape[1]
    for _ in range(DEPTH):
        xn = rms_norm(h, norm1_w)
        proj = xn @ w_in
        q, k, v, r, a_low, hy_in, gates = jnp.split(proj, IN_SPLITS, axis=-1)
        o_gla = gla_branch(q, k, v, r, a_low, gla_gate_w2, gla_gate_b, gla_norm_w)
        kern = hyena_filters(L, hy_freq, hy_ffn_w1, hy_ffn_b1, hy_ffn_w2, hy_ffn_b2, hy_ffn_w3, hy_decay)
        o_hy = hyena_branch(hy_in, hy_conv_w, hy_conv_b, kern, hy_bias)
        g_gla, g_hy = jnp.split(gates, 2, axis=-1)
        merged = jax.nn.sigmoid(g_gla) * (o_gla @ w_branch_gla) + jax.nn.sigmoid(g_hy) * (o_hy @ w_branch_hy)
        h = h + merged @ w_out
        hn = rms_norm(h, norm2_w)
        h = h + moe_ffn(hn, router_w, router_b, w_gate_up, b_gate_up, w_down, b_down)
    return rms_norm(h, norm_f_w)
```

```cpp
#include <hip/hip_runtime.h>
#include <cstdio>
#include <cstdint>

#ifndef MK_N_LAUNCHES
#define MK_N_LAUNCHES 1
#endif

#ifndef PROBE_PHASE
#define PROBE_PHASE -1
#endif
#define LAS __attribute__((address_space(3)))
typedef unsigned short bf16_t;
typedef short bf16x8 __attribute__((ext_vector_type(8)));
typedef float f32x4 __attribute__((ext_vector_type(4)));
typedef float f32x16 __attribute__((ext_vector_type(16)));
typedef unsigned u32x4 __attribute__((ext_vector_type(4)));
typedef unsigned u32x2 __attribute__((ext_vector_type(2)));
typedef int i32x8 __attribute__((ext_vector_type(8)));
typedef float f32x2 __attribute__((ext_vector_type(2)));
typedef int i32x4 __attribute__((ext_vector_type(4)));
constexpr float W8_SCALE = 32.f, W8_INV = 1.f / 32.f;
__device__ __forceinline__ unsigned pk4_fp8(float a, float b, float c, float d) { int v = __builtin_amdgcn_cvt_pk_fp8_f32(a, b, 0, false); v = __builtin_amdgcn_cvt_pk_fp8_f32(c, d, v, true); return (unsigned)v; }

constexpr int T_ = 32768, D_ = 1024, L_ = 4096, NB_ = 8;
constexpr int NTHR = 512;
constexpr int NEXP = 32, TOPK = 4;
constexpr int MAXROWS = T_ * TOPK + NEXP * 256;
constexpr int IN_TOTAL = 8224;

constexpr int REG_BYTES = 150528, MISC_OFF = REG_BYTES, MISC_BYTES = 8192, LDS_BYTES = REG_BYTES + MISC_BYTES;
constexpr int MW_Q = 8, MW_CNT = 16, MW_BASE = 48, MW_ROWB = 80, MW_RT = 113, MW_SEL = 256, MW_TILE = 1792;

constexpr size_t MiB = 1048576;
constexpr size_t WS_CTL = 0, CTL_BYTES = 65536;
constexpr size_t WS_EIDX = 1 * MiB, WS_POSE = WS_EIDX + MiB / 2, WS_WGT = 2 * MiB, WS_DEST = WS_WGT + MiB / 2, WS_SUMSQ = 3 * MiB;
constexpr size_t WS_R1 = 5 * MiB;
constexpr size_t WS_QT = WS_R1, WS_KT = WS_R1 + 64 * MiB, WS_KE = WS_R1 + 128 * MiB;
constexpr size_t WS_A = 197 * MiB, WS_B = WS_A + 272 * MiB, WS_C = WS_B + 272 * MiB, WS_END = WS_C + 256 * MiB;
constexpr size_t WS_PHY = WS_A, WS_PR = WS_A + 192 * MiB, WS_WBIN = WS_A + 256 * MiB;
constexpr size_t WS_OF = WS_C, WS_OB = WS_C + 192 * MiB, WS_Y = WS_A + 128 * MiB;
constexpr size_t WS_HNS = WS_A, WS_OUTP = WS_A;
constexpr size_t WS_PQKV = WS_B, WS_PG = WS_B, WS_ALOW = WS_B + 256 * MiB,
     WS_WBBG = WS_B + 260 * MiB, WS_WBBH = WS_B + 262 * MiB, WS_WBOUT = WS_B + 264 * MiB;
constexpr size_t WS_HRAW = WS_C + 128 * MiB  , WS_DEC = WS_B + 266 * MiB, WS_XN8 = WS_B + 224 * MiB, WS_WBIN8 = WS_WBIN + 12 * MiB, WS_LIST = WS_B + 64 * MiB;
constexpr size_t WS_WBGU = WS_B + 128 * MiB, WS_WBDN = WS_B + 192 * MiB;
constexpr size_t WS_OGLA = WS_R1, WS_OHY = WS_R1 + 64 * MiB, WS_ACT = WS_R1;
constexpr size_t WS_Z = WS_C, WS_M1 = WS_C, WS_HN = WS_C, WS_X0C = WS_C + 64 * MiB, WS_MERGED = WS_X0C, WS_RT = WS_C + 128 * MiB, WS_XN = WS_C + 192 * MiB, WS_H = WS_RT;
constexpr size_t WS_ZT = WS_Z, WS_YT = WS_Y, WS_RN = WS_CTL + 65536;
constexpr int CW_BAR = 0;
constexpr int CW_GCOUNT = 4096;
constexpr int CW_CONVQ = 4160;
constexpr int CW_CVTQ = 4352;

__device__ __forceinline__ float bf2f(bf16_t b) { return __uint_as_float(((unsigned)b) << 16); }
__device__ __forceinline__ float bflo(unsigned w) { return __uint_as_float(w << 16); }
__device__ __forceinline__ float bfhi(unsigned w) { return __uint_as_float(w & 0xffff0000u); }
typedef __bf16 bf16v2_t __attribute__((ext_vector_type(2)));
__device__ __forceinline__ bf16_t f2bf(float f) { return __builtin_bit_cast(unsigned short, (__bf16)f); }
__device__ __forceinline__ unsigned pk2(float lo, float hi) { bf16v2_t v; v.x = (__bf16)lo; v.y = (__bf16)hi; return __builtin_bit_cast(unsigned, v); }
__device__ __forceinline__ unsigned pkc(float lo, float hi) { bf16v2_t v; v.x = (__bf16)lo; v.y = (__bf16)hi; return __builtin_bit_cast(unsigned, v); }
__device__ __forceinline__ bf16x8 pack8(const f32x16& x, int s8) { u32x4 p; p.x = pkc(x[s8], x[s8 + 1]); p.y = pkc(x[s8 + 2], x[s8 + 3]); p.z = pkc(x[s8 + 4], x[s8 + 5]); p.w = pkc(x[s8 + 6], x[s8 + 7]); return __builtin_bit_cast(bf16x8, p); }
__device__ __forceinline__ int swap23(int k) { return 8 * ((k >> 2) & 1) + 4 * (k >> 3) + (k & 3); }
__device__ __forceinline__ float sigmoidf_(float x) { return __builtin_amdgcn_rcpf(1.f + __expf(-x)); }
__device__ __forceinline__ float wave_sum(float v) {
#pragma unroll
    for (int o = 32; o > 0; o >>= 1) v += __shfl_xor(v, o);
    return v;
}

namespace pg8 {
#define PG8_LAS __attribute__((address_space(3)))
constexpr int BM = 256, BK = 64, HALF = 128, HTB = HALF * BK * 2, STAGE_BYTES = 8 * HTB, NXCD = 8, WGM = 8;
__host__ __device__ __forceinline__ int lds_byte(int r, int c) { const int st = (r >> 4) * 2 + (c >> 5), rr = r & 15, cc = c & 31, ob = rr * 64 + cc * 2; return st * 1024 + (ob ^ (((ob >> 9) & 1) << 5)); }
__host__ __device__ __forceinline__ void stage_rc(int b, int& R, int& C) { const int st = b / 1024, sb = b % 1024, swz = sb ^ (((sb >> 9) & 1) << 5); R = (st >> 1) * 16 + swz / 64; C = (st & 1) * 32 + (swz % 64) / 2; }
__host__ __device__ __forceinline__ int perm32(int rho) { const int n = rho >> 4, i = rho & 15; return 8 * (i >> 2) + 4 * n + (i & 3); }

struct Unit { int pm, pn, e; };

__device__ __forceinline__ void tile_of(int wgid, int nM, int nN, int& pm, int& pn) {
    const int nwg = nM * nN;
    { const int q = nwg / NXCD, r = nwg % NXCD, xcd = wgid % NXCD, off = wgid / NXCD; wgid = (xcd < r ? xcd * (q + 1) : r * (q + 1) + (xcd - r) * q) + off; }
    const int nig = WGM * nN, gid = wgid / nig, fm = gid * WGM, gsz = (nM - fm) < WGM ? (nM - fm) : WGM;
    pm = fm + ((wgid % nig) % gsz); pn = (wgid % nig) / gsz;
}
struct StaticOrder {
    static constexpr bool GATHER = false;
    const bf16_t* A; const bf16_t* Bt; int K, pitch, nM, nN, nwg, G, c;
    __device__ void init(const void* A_, const void* Bt_, int M, int N, int K_, int G_, int c_, int esz = 2) { A = (const bf16_t*)A_; Bt = (const bf16_t*)Bt_; K = K_; pitch = esz * K_; nM = M / BM; nN = N / BM; nwg = nM * nN; G = G_; c = c_; }
    __device__ __forceinline__ bool next(int i, Unit& u) const {
        const long Lq = (long)i * G + c; if (Lq >= nwg) return false;
        tile_of((int)Lq, nM, nN, u.pm, u.pn); u.e = 0; return true;
    }
    __device__ __forceinline__ const void* a_base() const { return A; }
    __device__ __forceinline__ const void* b_base() const { return Bt; }
    __device__ __forceinline__ unsigned a_off(const Unit& u) const { return (unsigned)(u.pm * BM) * (unsigned)pitch; }
    __device__ __forceinline__ unsigned b_off(const Unit& u) const { return (unsigned)(u.pn * BM) * (unsigned)pitch; }
};
struct DualOrder {
    static constexpr bool GATHER = false;
    const bf16_t* A; const bf16_t* Bt; unsigned a2, b2; int K, pitch, nM, nN, nwg, G, c;
    __device__ void init(const bf16_t* A_, const bf16_t* Bt_, unsigned a2_, unsigned b2_, int M, int N, int K_, int G_, int c_) { A = A_; Bt = Bt_; a2 = a2_; b2 = b2_; K = K_; pitch = 2 * K_; nM = M / BM; nN = N / BM; nwg = nM * nN; G = G_; c = c_; }
    __device__ __forceinline__ bool next(int i, Unit& u) const {
        const long Lq = (long)(i >> 1) * G + c; if (Lq >= nwg) return false;
        tile_of((int)Lq, nM, nN, u.pm, u.pn); u.e = i & 1; return true;
    }
    __device__ __forceinline__ const void* a_base() const { return A; }
    __device__ __forceinline__ const void* b_base() const { return Bt; }
    __device__ __forceinline__ unsigned a_off(const Unit& u) const { return (unsigned)(u.pm * BM) * (unsigned)pitch + (u.e ? a2 : 0u); }
    __device__ __forceinline__ unsigned b_off(const Unit& u) const { return (unsigned)(u.pn * BM) * (unsigned)pitch + (u.e ? b2 : 0u); }
};
struct GroupedOrder {
    static constexpr bool GATHER = false;
    const void* A; const void* Bt; const LAS unsigned char* tile_e; int K, pitch, N, nM, nN, nwg, G, c;
    __device__ void init(const void* A_, const void* Bt_, const LAS unsigned char* te, int RT, int N_, int K_, int esz, int G_, int c_) { A = A_; Bt = Bt_; tile_e = te; K = K_; pitch = esz * K_; N = N_; nM = RT; nN = N_ / BM; nwg = nM * nN; G = G_; c = c_; }
    __device__ __forceinline__ bool next(int i, Unit& u) const {
        const long Lq = (long)i * G + c; if (Lq >= nwg) return false;
        tile_of((int)Lq, nM, nN, u.pm, u.pn); u.e = tile_e[u.pm]; return true;
    }
    __device__ __forceinline__ const void* a_base() const { return A; }
    __device__ __forceinline__ const void* b_base() const { return Bt; }
    __device__ __forceinline__ unsigned a_off(const Unit& u) const { return (unsigned)(u.pm * BM) * (unsigned)pitch; }
    __device__ __forceinline__ unsigned b_off(const Unit& u) const { return (unsigned)(u.e * N + u.pn * BM) * (unsigned)pitch; }
};

struct GatherOrder {
    static constexpr bool GATHER = true;
    const void* A; const void* Bt; const LAS unsigned char* tile_e; const LAS unsigned char* slot; const LAS int* tab; int K, pitch, N, nM, nN, nwg, G, c;
    __device__ void init(const void* A_, const void* Bt_, const LAS unsigned char* te, const LAS unsigned char* sl, const LAS int* tb, int RT, int N_, int K_, int esz, int G_, int c_) { A = A_; Bt = Bt_; tile_e = te; slot = sl; tab = tb; K = K_; pitch = esz * K_; N = N_; nM = RT; nN = N_ / BM; nwg = nM * nN; G = G_; c = c_; }
    __device__ __forceinline__ bool next(int i, Unit& u) const {
        const long Lq = (long)i * G + c; if (Lq >= nwg) return false;
        tile_of((int)Lq, nM, nN, u.pm, u.pn); u.e = tile_e[u.pm]; return true;
    }
    __device__ __forceinline__ const void* a_base() const { return A; }
    __device__ __forceinline__ const void* b_base() const { return Bt; }
    __device__ __forceinline__ unsigned a_off(const Unit&) const { return 0u; }
    __device__ __forceinline__ unsigned b_off(const Unit& u) const { return (unsigned)(u.e * N + u.pn * BM) * (unsigned)pitch; }
    __device__ __forceinline__ int row_of(const Unit& u, int r) const { return tab[(int)slot[u.pm] * 256 + r]; }
};

__device__ __forceinline__ unsigned cvt_pk_bf16(float lo, float hi) { unsigned r; asm volatile("v_cvt_pk_bf16_f32 %0, %1, %2" : "=v"(r) : "v"(lo), "v"(hi)); return r; }

template <class E, class = void> struct EpiTrans { static constexpr bool value = false; };
template <class E> struct EpiTrans<E, decltype((void)E::TRANS)> { static constexpr bool value = E::TRANS; };
template <class Epi, class Sched, bool F8 = false>
__device__ __forceinline__ void gemm_phase(PG8_LAS unsigned char* lds, const Sched& S, const Epi& E) {
    constexpr bool TR = EpiTrans<Epi>::value;
    static_assert(!(TR && (F8 || Sched::GATHER)), "transposed output: bf16 dense only");
    int lane; asm volatile("v_mbcnt_lo_u32_b32 %0, -1, 0\n\tv_mbcnt_hi_u32_b32 %0, -1, %0" : "=v"(lane));
    const int wid = __builtin_amdgcn_readfirstlane(threadIdx.x >> 6), tid = wid * 64 + lane, wr = wid >> 2, wc = wid & 3, fr = lane & 15, fq = lane >> 4;
    const int pitch = S.pitch, nt = pitch / 128;
    unsigned voffA[2][2], voffN[2][2], voffB[2]; int rowA[2], colA[2];
#pragma unroll
    for (int i = 0; i < 2; ++i) { int R, C; stage_rc(tid * 16 + i * 8192, R, C); const int Rp = Epi::PERM ? ((R & ~31) + perm32(R & 31)) : R, Rb = TR ? R : Rp, Ra = TR ? Rp : R;
        rowA[i] = R; colA[i] = C; voffB[i] = (unsigned)(Rb * pitch + C * 2);
#pragma unroll
        for (int hf = 0; hf < 2; ++hf) { voffA[hf][i] = (unsigned)((Ra + HALF * hf) * pitch + C * 2); voffN[hf][i] = voffA[hf][i]; } }
    const unsigned kstep = 128u, hstep = (unsigned)(HALF * pitch);
    const unsigned ldsw = (unsigned)wid * 1024u;
    const int aoff = lds_byte(wr * 64 + fr, fq * 8), boff = lds_byte(wc * 32 + fr, fq * 8);
    const __amdgpu_buffer_rsrc_t rA = __builtin_amdgcn_make_buffer_rsrc((void*)S.a_base(), 0, 0x7FFFFFFF, 0x00020000), rB = __builtin_amdgcn_make_buffer_rsrc((void*)S.b_base(), 0, 0x7FFFFFFF, 0x00020000);
#define PG8_SA(b, h) (((b) * 2 + (h)) * HTB)
#define PG8_SB(b, h) ((4 + (b) * 2 + (h)) * HTB)
#define PG8_SBR(b, h) (((b) * 2 + (h)) * HTB)
    const PG8_LAS unsigned char* ldsB = lds + 4 * HTB + boff; asm volatile("" : "+v"(ldsB));
#define PG8_STAGE(bufoff, rsrc, soff, voff) do { _Pragma("unroll") for (int _i = 0; _i < 2; ++_i) \
        __builtin_amdgcn_raw_ptr_buffer_load_lds(rsrc, (PG8_LAS void*)(lds + (bufoff) + ldsw + _i * 8192), 16, (voff)[_i], (int)(soff), 0, 0); } while (0)
#define PG8_GATHER_OFFS(dst, unit) do { if constexpr (Sched::GATHER) { _Pragma("unroll") for (int _h = 0; _h < 2; ++_h) _Pragma("unroll") for (int _i = 0; _i < 2; ++_i) \
        dst[_h][_i] = (unsigned)(S.row_of(unit, rowA[_i] + HALF * _h) * pitch + colA[_i] * 2); } } while (0)
#define PG8_LDA(dst, b, h) do { _Pragma("unroll") for (int m = 0; m < 4; ++m) { if constexpr (F8) { const i32x4 _lo = *(const PG8_LAS i32x4*)(lds + PG8_SA(b, h) + aoff + m * 2048), _hi = *(const PG8_LAS i32x4*)(lds + PG8_SA(b, h) + aoff + m * 2048 + 1024); dst##8[m] = __builtin_shufflevector(_lo, _hi, 0, 1, 2, 3, 4, 5, 6, 7); } \
        else { _Pragma("unroll") for (int k = 0; k < 2; ++k) dst[m][k] = *(const PG8_LAS bf16x8*)(lds + PG8_SA(b, h) + aoff + m * 2048 + k * 1024); } } } while (0)
#define PG8_LDB(dst, b, h) do { _Pragma("unroll") for (int n = 0; n < 2; ++n) { if constexpr (F8) { const i32x4 _lo = *(const PG8_LAS i32x4*)(ldsB + PG8_SBR(b, h) + n * 2048), _hi = *(const PG8_LAS i32x4*)(ldsB + PG8_SBR(b, h) + n * 2048 + 1024); dst##8[n] = __builtin_shufflevector(_lo, _hi, 0, 1, 2, 3, 4, 5, 6, 7); } \
        else { _Pragma("unroll") for (int k = 0; k < 2; ++k) dst[n][k] = *(const PG8_LAS bf16x8*)(ldsB + PG8_SBR(b, h) + n * 2048 + k * 1024); } } } while (0)
#define PG8_MMA(ai, bj, At, Bt) do { __builtin_amdgcn_s_setprio(1); _Pragma("unroll") for (int m = 0; m < 4; ++m) _Pragma("unroll") for (int n = 0; n < 2; ++n) { if constexpr (F8) { \
            asm volatile("v_mfma_scale_f32_16x16x128_f8f6f4 %0, %1, %2, %0, %3, %3 op_sel_hi:[0,0,0]" : "+v"(acc[ai][bj][m][n]) : "v"(Bt##8[n]), "v"(At##8[m]), "v"(sc8)); } \
        else { _Pragma("unroll") for (int k = 0; k < 2; ++k) { if constexpr (TR) acc[ai][bj][m][n] = __builtin_amdgcn_mfma_f32_16x16x32_bf16(At[m][k], Bt[n][k], acc[ai][bj][m][n], 0, 0, 0); \
            else acc[ai][bj][m][n] = __builtin_amdgcn_mfma_f32_16x16x32_bf16(Bt[n][k], At[m][k], acc[ai][bj][m][n], 0, 0, 0); } } } \
        __builtin_amdgcn_s_setprio(0); } while (0)
#define PG8_WAIT_V(n) asm volatile("s_waitcnt vmcnt(" #n ")" ::: "memory")
#define PG8_WAIT_V8R() do { if (relax_now) asm volatile("s_waitcnt vmcnt(%0)" :: "n"(8 + Epi::NSTORES) : "memory"); else asm volatile("s_waitcnt vmcnt(8)" ::: "memory"); } while (0)
#define PG8_WAIT_L(n) asm volatile("s_waitcnt lgkmcnt(" #n ")" ::: "memory")
#define PG8_BAR __builtin_amdgcn_s_barrier()
#define PG8_SCHED __builtin_amdgcn_sched_barrier(0)
    Unit cur, nxt; int ui = 0; bool relax = false;
    if (!S.next(0, cur)) return;
    f32x4 acc[2][2][4][2];
#pragma unroll
    for (int a = 0; a < 2; ++a)
#pragma unroll
        for (int b = 0; b < 2; ++b)
#pragma unroll
            for (int m = 0; m < 4; ++m)
#pragma unroll
                for (int n = 0; n < 2; ++n) acc[a][b][m][n] = (f32x4){0.f, 0.f, 0.f, 0.f};
    bf16x8 At[4][2], B0[2][2], B1[2][2]; i32x8 At8[4], B08[2], B18[2];
    const int sc8 = 0x7F7F7F7F;
    unsigned cA = S.a_off(cur), cB = S.b_off(cur);
    PG8_GATHER_OFFS(voffA, cur);
    PG8_STAGE(PG8_SB(0, 0), rB, cB, voffB); PG8_STAGE(PG8_SB(0, 1), rB, cB + hstep, voffB); PG8_STAGE(PG8_SA(0, 0), rA, cA, voffA[0]); PG8_STAGE(PG8_SA(0, 1), rA, cA, voffA[1]);
    if (wr == 1) PG8_BAR;
    PG8_WAIT_V(2); PG8_BAR;
    PG8_STAGE(PG8_SB(1, 0), rB, cB + kstep, voffB); PG8_STAGE(PG8_SA(1, 0), rA, cA + kstep, voffA[0]); PG8_STAGE(PG8_SB(1, 1), rB, cB + hstep + kstep, voffB);
    PG8_WAIT_V(6); PG8_BAR;
    for (;;) {
        const bool has_next = S.next(ui + 1, nxt);
        const unsigned nA = has_next ? S.a_off(nxt) : cA, nB = has_next ? S.b_off(nxt) : cB;
        if constexpr (Sched::GATHER) { if (has_next) { PG8_GATHER_OFFS(voffN, nxt); } else {
#pragma unroll
            for (int hf = 0; hf < 2; ++hf) { voffN[hf][0] = voffA[hf][0]; voffN[hf][1] = voffA[hf][1]; } } }
        for (int t = 0; t < nt; t += 2) {
            const bool last = (t == nt - 2), relax_now = relax && (t == 0);
            unsigned v2[2][2];
#pragma unroll
            for (int hf = 0; hf < 2; ++hf) { if constexpr (Sched::GATHER) { v2[hf][0] = last ? voffN[hf][0] : voffA[hf][0]; v2[hf][1] = last ? voffN[hf][1] : voffA[hf][1]; } else { v2[hf][0] = voffA[hf][0]; v2[hf][1] = voffA[hf][1]; } }
            const unsigned a1 = cA + (unsigned)(t + 1) * kstep;
            const unsigned a2 = last ? nA : cA + (unsigned)(t + 2) * kstep, b2 = last ? nB : cB + (unsigned)(t + 2) * kstep;
            const unsigned a3 = a2 + kstep, b3 = b2 + kstep;
            PG8_LDB(B0, 0, 0); PG8_LDB(B1, 0, 1); PG8_SCHED; PG8_LDA(At, 0, 0); PG8_STAGE(PG8_SA(1, 1), rA, a1, voffA[1]);
            PG8_WAIT_V8R(); PG8_WAIT_L(0); PG8_BAR; PG8_MMA(0, 0, At, B0); PG8_MMA(0, 1, At, B1); PG8_BAR; PG8_SCHED;
            PG8_LDA(At, 0, 1); PG8_STAGE(PG8_SB(0, 0), rB, b2, voffB); PG8_STAGE(PG8_SB(0, 1), rB, b2 + hstep, voffB); PG8_STAGE(PG8_SA(0, 0), rA, a2, v2[0]);
            PG8_WAIT_V8R(); PG8_WAIT_L(0); PG8_BAR; PG8_MMA(1, 0, At, B0); PG8_MMA(1, 1, At, B1); PG8_BAR; PG8_SCHED;
            PG8_LDB(B0, 1, 0); PG8_LDB(B1, 1, 1); PG8_SCHED; PG8_LDA(At, 1, 0); PG8_STAGE(PG8_SA(0, 1), rA, a2, v2[1]);
            PG8_WAIT_V(8); PG8_WAIT_L(0); PG8_BAR; PG8_MMA(0, 0, At, B0); PG8_MMA(0, 1, At, B1); PG8_BAR; PG8_SCHED;
            PG8_LDA(At, 1, 1); PG8_STAGE(PG8_SB(1, 0), rB, b3, voffB); PG8_STAGE(PG8_SB(1, 1), rB, b3 + hstep, voffB); PG8_STAGE(PG8_SA(1, 0), rA, a3, v2[0]);
            PG8_WAIT_V(8); PG8_WAIT_L(0); PG8_BAR; PG8_MMA(1, 0, At, B0); PG8_MMA(1, 1, At, B1); PG8_BAR; PG8_SCHED;
        }
        if (wr == 0) PG8_BAR;
        if constexpr (F8) asm volatile("s_nop 15\n\ts_nop 3" ::: "memory");
        { int l2; asm volatile("v_mbcnt_lo_u32_b32 %0, -1, 0\n\tv_mbcnt_hi_u32_b32 %0, -1, %0" : "=v"(l2)); E(acc, cur, wr, wc, l2 & 15, l2 >> 4); if (PROBE_PHASE == 100) E(acc, cur, wr, wc, l2 & 15, l2 >> 4); }
        if (!has_next) break;
        if (!(Epi::DUAL && cur.e == 0)) {
#pragma unroll
        for (int a = 0; a < 2; ++a)
#pragma unroll
            for (int b = 0; b < 2; ++b)
#pragma unroll
                for (int m = 0; m < 4; ++m)
#pragma unroll
                    for (int n = 0; n < 2; ++n) acc[a][b][m][n] = (f32x4){0.f, 0.f, 0.f, 0.f};
        }
        relax = Epi::DUAL ? (cur.e == 1) : true;
        cur = nxt; cA = nA; cB = nB; ++ui;
        if constexpr (Sched::GATHER) {
#pragma unroll
            for (int hf = 0; hf < 2; ++hf) { voffA[hf][0] = voffN[hf][0]; voffA[hf][1] = voffN[hf][1]; } }
        if (wr == 1) PG8_BAR;
    }
    PG8_WAIT_V(0);
    PG8_BAR;
#undef PG8_SA
#undef PG8_SB
#undef PG8_SBR
#undef PG8_STAGE
#undef PG8_GATHER_OFFS
#undef PG8_LDA
#undef PG8_LDB
#undef PG8_MMA
#undef PG8_WAIT_V
#undef PG8_WAIT_V8R
#undef PG8_WAIT_L
#undef PG8_BAR
#undef PG8_SCHED
}

__device__ __forceinline__ void store16_pair(unsigned char* px, unsigned char* py, u32x2 a, u32x2 b, int fq) {
    const auto r0 = __builtin_amdgcn_permlane16_swap(a.x, b.x, false, false);
    const auto r1 = __builtin_amdgcn_permlane16_swap(a.y, b.y, false, false);
    u32x4 w; w.x = r0[0]; w.y = r1[0]; w.z = r0[1]; w.w = r1[1];
    *(u32x4*)((fq & 1) ? (py - 8) : px) = w;
}
struct EpiInProj {
    static constexpr int NSTORES = 16;
    static constexpr bool DUAL = false;
    static constexpr bool PERM = true;
    bf16_t *qkv, *r, *hy, *g; int pn_off;
    __device__ __forceinline__ void operator()(const f32x4 (&acc)[2][2][4][2], const Unit& u0, int wr, int wc, int fr, int fq) const {
        Unit u = u0; u.pn += pn_off;
        bf16_t* base; int ldc, ct;
        if (u.pn < 8) { base = qkv; ldc = 2048; ct = u.pn; } else if (u.pn < 12) { base = r; ldc = 1024; ct = u.pn - 8; }
        else if (u.pn < 16) { base = g; ldc = 1024; ct = u.pn - 12; } else { base = hy; ldc = 2048; ct = u.pn - 16; }
        const float sc = (u.pn < 2) ? 0.08838834764831845f : 1.f;
        const int row0 = u.pm * BM + wr * 64 + fr, col0 = ct * BM + wc * 32 + 8 * fq;
#pragma unroll
        for (int ai = 0; ai < 2; ++ai)
#pragma unroll
            for (int m = 0; m < 4; ++m) { bf16_t* rowp = base + (size_t)(row0 + ai * HALF + m * 16) * ldc + col0;
#pragma unroll
                for (int bj = 0; bj < 2; ++bj) { const f32x4 v0 = acc[ai][bj][m][0] * sc, v1 = acc[ai][bj][m][1] * sc; u32x4 w;
                    w.x = cvt_pk_bf16(v0[0], v0[1]); w.y = cvt_pk_bf16(v0[2], v0[3]); w.z = cvt_pk_bf16(v1[0], v1[1]); w.w = cvt_pk_bf16(v1[2], v1[3]);
                    *(u32x4*)(rowp + bj * HALF) = w; } }
    }
};
struct EpiHyT {
    static constexpr int NSTORES = 16;
    static constexpr bool DUAL = false, PERM = true, TRANS = true;
    bf16_t* XT;
    __device__ __forceinline__ void operator()(const f32x4 (&acc)[2][2][4][2], const Unit& u, int wr, int wc, int fr, int fq) const {
        const int row0 = u.pm * BM + wr * 64 + 8 * fq, col0 = u.pn * BM + wc * 32 + fr;
#pragma unroll
        for (int bj = 0; bj < 2; ++bj)
#pragma unroll
            for (int n = 0; n < 2; ++n) { bf16_t* colp = XT + (size_t)(col0 + bj * HALF + n * 16) * T_ + row0;
#pragma unroll
                for (int ai = 0; ai < 2; ++ai)
#pragma unroll
                    for (int mp = 0; mp < 2; ++mp) { const f32x4 v0 = acc[ai][bj][2 * mp][n], v1 = acc[ai][bj][2 * mp + 1][n]; u32x4 w;
                        w.x = cvt_pk_bf16(v0[0], v0[1]); w.y = cvt_pk_bf16(v0[2], v0[3]); w.z = cvt_pk_bf16(v1[0], v1[1]); w.w = cvt_pk_bf16(v1[2], v1[3]);
                        *(u32x4*)(colp + ai * HALF + mp * 32) = w; } }
    }
};
struct EpiGates8 {
    static constexpr int NSTORES = 8;
    static constexpr bool CONT64 = false;
    static constexpr bool PERM = true, DUAL = false;
    unsigned char* G8;
    __device__ __forceinline__ void operator()(const f32x4 (&acc)[2][2][4][2], const Unit& u, int wr, int wc, int fr, int fq) const {
        const int row0 = u.pm * BM + wr * 64 + fr, col0 = u.pn * BM + wc * 32 + 8 * fq;
#pragma unroll
        for (int ai = 0; ai < 2; ++ai)
#pragma unroll
            for (int mp = 0; mp < 2; ++mp) { unsigned char* rowx = G8 + (size_t)(row0 + ai * HALF + (2 * mp) * 16) * 2048 + col0; unsigned char* rowy = rowx + 16 * 2048;
#pragma unroll
                for (int bj = 0; bj < 2; ++bj) { u32x2 a, b;
                    { const f32x4 v0 = acc[ai][bj][2 * mp][0] * W8_INV, v1 = acc[ai][bj][2 * mp][1] * W8_INV; a.x = pk4_fp8(v0[0], v0[1], v0[2], v0[3]); a.y = pk4_fp8(v1[0], v1[1], v1[2], v1[3]); }
                    { const f32x4 v0 = acc[ai][bj][2 * mp + 1][0] * W8_INV, v1 = acc[ai][bj][2 * mp + 1][1] * W8_INV; b.x = pk4_fp8(v0[0], v0[1], v0[2], v0[3]); b.y = pk4_fp8(v1[0], v1[1], v1[2], v1[3]); }
                    store16_pair(rowx + bj * HALF, rowy + bj * HALF, a, b, fq); } }
    }
};
struct EpiMerge {
    static constexpr int NSTORES = 16;
    static constexpr bool PERM = true, DUAL = true;
    const unsigned char* g; bf16_t* O;
    __device__ __forceinline__ void operator()(f32x4 (&acc)[2][2][4][2], const Unit& u, int wr, int wc, int fr, int fq) const {
        const int row0 = u.pm * BM + wr * 64 + fr, col0 = u.pn * BM + wc * 32 + 8 * fq;
#pragma unroll
        for (int ai = 0; ai < 2; ++ai)
#pragma unroll
            for (int m = 0; m < 4; ++m) { const size_t row = (size_t)(row0 + ai * HALF + m * 16);
#pragma unroll
                for (int bj = 0; bj < 2; ++bj) { const int col = col0 + bj * HALF;
                    const u32x2 g2w = *(const u32x2*)(g + row * 2048 + 1024 + col);
                    const f32x2 a0 = __builtin_amdgcn_cvt_pk_f32_fp8((int)g2w.x, false), a1 = __builtin_amdgcn_cvt_pk_f32_fp8((int)g2w.x, true), a2 = __builtin_amdgcn_cvt_pk_f32_fp8((int)g2w.y, false), a3 = __builtin_amdgcn_cvt_pk_f32_fp8((int)g2w.y, true);
                    float e2[8] = {__expf(-a0[0]), __expf(-a0[1]), __expf(-a1[0]), __expf(-a1[1]), __expf(-a2[0]), __expf(-a2[1]), __expf(-a3[0]), __expf(-a3[1])};
                    if (u.e == 0) { const u32x2 g1w = *(const u32x2*)(g + row * 2048 + col);
                        const f32x2 c0 = __builtin_amdgcn_cvt_pk_f32_fp8((int)g1w.x, false), c1 = __builtin_amdgcn_cvt_pk_f32_fp8((int)g1w.x, true), c2 = __builtin_amdgcn_cvt_pk_f32_fp8((int)g1w.y, false), c3 = __builtin_amdgcn_cvt_pk_f32_fp8((int)g1w.y, true);
                        const float e1[8] = {__expf(-c0[0]), __expf(-c0[1]), __expf(-c1[0]), __expf(-c1[1]), __expf(-c2[0]), __expf(-c2[1]), __expf(-c3[0]), __expf(-c3[1])};
#pragma unroll
                        for (int i = 0; i < 4; ++i) { acc[ai][bj][m][0][i] *= (1.f + e2[i]) * __builtin_amdgcn_rcpf(1.f + e1[i]); acc[ai][bj][m][1][i] *= (1.f + e2[4 + i]) * __builtin_amdgcn_rcpf(1.f + e1[4 + i]); } }
                    else { f32x4 v0, v1;
#pragma unroll
                        for (int i = 0; i < 4; ++i) { v0[i] = acc[ai][bj][m][0][i] * __builtin_amdgcn_rcpf(1.f + e2[i]); v1[i] = acc[ai][bj][m][1][i] * __builtin_amdgcn_rcpf(1.f + e2[4 + i]); }
                        u32x4 w; w.x = cvt_pk_bf16(v0[0], v0[1]); w.y = cvt_pk_bf16(v0[2], v0[3]); w.z = cvt_pk_bf16(v1[0], v1[1]); w.w = cvt_pk_bf16(v1[2], v1[3]);
                        *(u32x4*)(O + row * 1024 + col) = w; } } }
    }
};
struct EpiResid {
    static constexpr int NSTORES = 16;
    static constexpr bool DUAL = false;
    static constexpr bool PERM = true;
    const float* x; bf16_t* H;
    __device__ __forceinline__ void operator()(const f32x4 (&acc)[2][2][4][2], const Unit& u, int wr, int wc, int fr, int fq) const {
        const int row0 = u.pm * BM + wr * 64 + fr, col0 = u.pn * BM + wc * 32 + 8 * fq;
#pragma unroll
        for (int ai = 0; ai < 2; ++ai)
#pragma unroll
            for (int m = 0; m < 4; ++m) { const size_t ro = (size_t)(row0 + ai * HALF + m * 16) * 1024 + col0;
#pragma unroll
                for (int bj = 0; bj < 2; ++bj) { const size_t o = ro + bj * HALF; const f32x4 v0 = acc[ai][bj][m][0] + *(const f32x4*)(x + o), v1 = acc[ai][bj][m][1] + *(const f32x4*)(x + o + 4); u32x4 w;
                    w.x = cvt_pk_bf16(v0[0], v0[1]); w.y = cvt_pk_bf16(v0[2], v0[3]); w.z = cvt_pk_bf16(v1[0], v1[1]); w.w = cvt_pk_bf16(v1[2], v1[3]);
                    *(u32x4*)(H + o) = w; } }
    }
};
struct EpiGateUp {
    static constexpr int NSTORES = 4;
    static constexpr bool CONT64 = false;
    static constexpr bool DUAL = false;
    static constexpr bool PERM = true;
    const float* bgu; unsigned char* ACT;
    __device__ __forceinline__ void operator()(const f32x4 (&acc)[2][2][4][2], const Unit& u, int wr, int wc, int fr, int fq) const {
        const int row0 = u.pm * BM + wr * 64 + fr, j0 = u.pn * HALF + wc * 32 + 8 * fq;
        const float* bg = bgu + (size_t)u.e * 2048 + j0;
        const f32x4 bg0 = *(const f32x4*)(bg), bg1 = *(const f32x4*)(bg + 4), bu0 = *(const f32x4*)(bg + 1024), bu1 = *(const f32x4*)(bg + 1028);
#pragma unroll
        for (int ai = 0; ai < 2; ++ai)
#pragma unroll
            for (int mp = 0; mp < 2; ++mp) { u32x2 pc[2];
#pragma unroll
                for (int h2 = 0; h2 < 2; ++h2) { const int m = 2 * mp + h2;
                    const f32x4 g0 = acc[ai][0][m][0] * W8_INV + bg0, g1 = acc[ai][0][m][1] * W8_INV + bg1, u0 = acc[ai][1][m][0] * W8_INV + bu0, u1 = acc[ai][1][m][1] * W8_INV + bu1;
                    float o[8];
#pragma unroll
                    for (int i = 0; i < 8; ++i) { float gt = i < 4 ? g0[i & 3] : g1[i & 3], up = i < 4 ? u0[i & 3] : u1[i & 3];
                        gt = fminf(gt, 7.f); up = fminf(fmaxf(up, -7.f), 7.f); o[i] = gt * sigmoidf_(1.702f * gt) * (up + 1.f); }
                    pc[h2].x = pk4_fp8(o[0], o[1], o[2], o[3]); pc[h2].y = pk4_fp8(o[4], o[5], o[6], o[7]); }
                unsigned char* rowx = ACT + (size_t)(row0 + ai * HALF + (2 * mp) * 16) * 1024 + j0;
                store16_pair(rowx, rowx + 16 * 1024, pc[0], pc[1], fq); }
    }
};
struct EpiDown {
    static constexpr int NSTORES = 8;
    static constexpr bool CONT64 = false;
    static constexpr bool DUAL = false;
    static constexpr bool PERM = true;
    const float* bd; unsigned char* O;
    __device__ __forceinline__ void operator()(const f32x4 (&acc)[2][2][4][2], const Unit& u, int wr, int wc, int fr, int fq) const {
        const int row0 = u.pm * BM + wr * 64 + fr, col0 = u.pn * BM + wc * 32 + 8 * fq;
        const float* bp = bd + (size_t)u.e * 1024 + col0;
#pragma unroll
        for (int bj = 0; bj < 2; ++bj) { const f32x4 b0 = *(const f32x4*)(bp + bj * HALF), b1 = *(const f32x4*)(bp + bj * HALF + 4);
#pragma unroll
            for (int ai = 0; ai < 2; ++ai)
#pragma unroll
                for (int mp = 0; mp < 2; ++mp) { unsigned char* rowx = O + (size_t)(row0 + ai * HALF + (2 * mp) * 16) * 1024 + col0 + bj * HALF; u32x2 a, b;
                    { const f32x4 v0 = acc[ai][bj][2 * mp][0] * W8_INV + b0, v1 = acc[ai][bj][2 * mp][1] * W8_INV + b1; a.x = pk4_fp8(v0[0], v0[1], v0[2], v0[3]); a.y = pk4_fp8(v1[0], v1[1], v1[2], v1[3]); }
                    { const f32x4 v0 = acc[ai][bj][2 * mp + 1][0] * W8_INV + b0, v1 = acc[ai][bj][2 * mp + 1][1] * W8_INV + b1; b.x = pk4_fp8(v0[0], v0[1], v0[2], v0[3]); b.y = pk4_fp8(v1[0], v1[1], v1[2], v1[3]); }
                    store16_pair(rowx, rowx + 16 * 1024, a, b, fq); } }
    }
};
}

#define XB_TMO      128
#define XB_XCNT(j)  (256  + 64 * (j))
#define XB_XSUB(j)  (1280 + 64 * (j))
#define XB_XGEN(j)  (2304 + 64 * (j))
#define XB_TOP      3328
#define XB_TOPGEN   3392
#define XCD_BAR_WORDS 3456
#define XB_SPIN_CAP (1u << 18)

__device__ __forceinline__ unsigned xb_ld(unsigned* p)              { return __hip_atomic_load(p, __ATOMIC_RELAXED, __HIP_MEMORY_SCOPE_AGENT); }
__device__ __forceinline__ unsigned xb_add(unsigned* p, unsigned v) { return __hip_atomic_fetch_add(p, v, __ATOMIC_RELAXED, __HIP_MEMORY_SCOPE_AGENT); }
__device__ __forceinline__ unsigned xb_xcc_id() { return (unsigned)__builtin_amdgcn_s_getreg((3 << 11) | 20) & 0xFu; }
#define XB_SPIN(cond, bar) do { unsigned _sp = 0; while (cond) { __builtin_amdgcn_s_sleep(1); \
    if ((++_sp & 255u) == 0u) { if (xb_ld(&(bar)[XB_TMO])) break; if (_sp > XB_SPIN_CAP) { atomicAdd(&(bar)[XB_TMO], 1u); break; } } } } while (0)

struct XcdBarrier { unsigned* bar; unsigned x; volatile LAS unsigned* st; };

__device__ __forceinline__ XcdBarrier xcd_barrier_post(unsigned* bar, volatile LAS unsigned* st) {
    XcdBarrier b; b.bar = bar; b.x = xb_xcc_id(); b.st = st;
    if (threadIdx.x == 0) (void)xb_add(&bar[XB_XCNT(b.x)], 1u);
    return b;
}
__device__ __forceinline__ void xcd_barrier_complete(unsigned* bar, unsigned x, unsigned& nloc, unsigned& nx) {
    const unsigned G = gridDim.x * gridDim.y * gridDim.z;
    unsigned sum, cnt, mine, sp = 0u;
    for (;;) {
        sum = 0u; cnt = 0u; mine = 0u;
#pragma unroll
        for (unsigned j = 0; j < 16; ++j) { const unsigned c = xb_ld(&bar[XB_XCNT(j)]); sum += c; cnt += (c > 0u) ? 1u : 0u; mine = (j == x) ? c : mine; }
        if (sum == G) break;
        __builtin_amdgcn_s_sleep(1);
        if ((++sp & 255u) == 0u) { if (xb_ld(&bar[XB_TMO])) break; if (sp > XB_SPIN_CAP) { atomicAdd(&bar[XB_TMO], 1u); break; } }
    }
    nloc = mine > 0u ? mine : 1u; nx = cnt > 0u ? cnt : 1u;
}
__device__ __forceinline__ void xcd_barrier(const XcdBarrier& b) {
    asm volatile("s_waitcnt vmcnt(0)" ::: "memory");
    __syncthreads();
    if (threadIdx.x == 0) {
        unsigned* bar = b.bar;
        __builtin_amdgcn_s_waitcnt(0);
        unsigned nloc = b.st[0], nx = b.st[1];
        if (nloc == 0u) { xcd_barrier_complete(bar, b.x, nloc, nx); b.st[0] = nloc; b.st[1] = nx; }
        const unsigned old = xb_add(&bar[XB_XSUB(b.x)], 1u);
        const unsigned gen = old / nloc;
        if (old + 1u == (gen + 1u) * nloc) {
            __builtin_amdgcn_fence(__ATOMIC_RELEASE, "agent");
            asm volatile("s_waitcnt vmcnt(0)" ::: "memory");
            const unsigned og = xb_add(&bar[XB_TOP], 1u);
            const unsigned tg = og / nx;
            if (og + 1u == (tg + 1u) * nx) xb_add(&bar[XB_TOPGEN], 1u);
            else XB_SPIN(xb_ld(&bar[XB_TOPGEN]) == tg, bar);
            __builtin_amdgcn_fence(__ATOMIC_ACQUIRE, "agent");
            xb_add(&bar[XB_XGEN(b.x)], 1u);
            asm volatile("s_waitcnt vmcnt(0)" ::: "memory");
        } else {
            XB_SPIN(xb_ld(&bar[XB_XGEN(b.x)]) == gen, bar);
            __builtin_amdgcn_fence(__ATOMIC_ACQUIRE, "agent");
            asm volatile("s_waitcnt vmcnt(0)" ::: "memory");
        }
    }
    __syncthreads();
}

struct Params { const float* in[27]; float* out; unsigned char* ws; int ph_lo, ph_hi; };
struct Frame {
    LAS unsigned char* lds; LAS unsigned* misc; int tid, lane, wave, bid, G;
    const float* const* in; float* out; unsigned char* ws; unsigned* ctl;
};
enum { I_X = 0, I_N1W, I_WIN, I_GW2, I_GB, I_GNW, I_CW, I_CB, I_FREQ, I_W1, I_B1, I_W2, I_B2, I_W3, I_DECAY, I_HBIAS, I_WBG, I_WBH, I_WOUT, I_N2W, I_RW, I_RB, I_WGU, I_BGU, I_WDN, I_BDN, I_NFW };

constexpr int CVT_SMALL = 352, CVT_ALL = 3424;
template <bool QUEUE>
__device__ void cvt_weights(const Frame& F, int it_lo, int it_hi) {
    constexpr int RSF = 513;
    LAS float* tile = (LAS float*)F.lds;
    for (int it0 = it_lo + F.bid; ; it0 += F.G) {
        int it = it0;
        if (QUEUE) { __syncthreads(); if (F.tid == 0) F.misc[MW_Q] = __hip_atomic_fetch_add(F.ctl + CW_CVTQ, 1u, __ATOMIC_RELAXED, __HIP_MEMORY_SCOPE_AGENT); __syncthreads(); it = it_lo + (int)F.misc[MW_Q]; }
        if (it >= it_hi) break;
        const float* src; int ld, kt, n0, kind; bf16_t* dst;
        bool f8 = it >= CVT_SMALL;
        if (it < 256) { kt = it & 15; n0 = (it >> 4) * 512; src = F.in[I_WIN]; ld = IN_TOTAL; kind = 1; dst = (bf16_t*)(F.ws + WS_WBIN); if (n0 >= 6144) { f8 = true; dst = (bf16_t*)(F.ws + WS_WBIN8 - (size_t)6144 * 1024); } }
        else if (it < 352) { const int j = it - 256, mat = j >> 5, rem = j & 31; kt = rem & 15; n0 = (rem >> 4) * 512; src = F.in[I_WBG + mat]; ld = 1024; kind = 0; dst = (bf16_t*)(F.ws + WS_WBBG + (size_t)mat * 2 * MiB); }
        else if (it < 2400) { const int j = it - 352, e = j >> 6, rem = j & 63; kt = rem & 15; n0 = (rem >> 4) * 512; src = F.in[I_WGU] + (size_t)e * 1024 * 2048; ld = 2048; kind = 2; dst = (bf16_t*)(F.ws + WS_WBGU + (size_t)e * 2048 * 1024); }
        else { const int j = it - 2400, e = j >> 5, rem = j & 31; kt = rem & 15; n0 = (rem >> 4) * 512; src = F.in[I_WDN] + (size_t)e * 1024 * 1024; ld = 1024; kind = 0; dst = (bf16_t*)(F.ws + WS_WBDN + (size_t)e * 1024 * 1024); }
        const int k0 = kt * 64;
        f32x4 v[16];
#pragma unroll
        for (int p = 0; p < 16; ++p) { const int e2 = F.tid + NTHR * p, k = e2 >> 7, nn = n0 + (e2 & 127) * 4; int sc = nn;
            if (kind == 1) sc = nn < 3072 ? nn : nn + 32;
            if (kind == 2) { const int pn = nn >> 8, x = nn & 255; sc = x < 128 ? 128 * pn + x : 1024 + 128 * pn + (x - 128); }
            v[p] = *(const f32x4*)(src + (size_t)(k0 + k) * ld + sc); }
        __syncthreads();
#pragma unroll
        for (int p = 0; p < 16; ++p) { const int e2 = F.tid + NTHR * p, k = e2 >> 7, n4 = (e2 & 127) * 4; LAS float* d = tile + k * RSF + n4; d[0] = v[p][0]; d[1] = v[p][1]; d[2] = v[p][2]; d[3] = v[p][3]; }
        __syncthreads();
#pragma unroll
        for (int q = 0; q < 8; ++q) { const int o = F.tid + NTHR * q, k8 = o & 7, n = o >> 3; const LAS float* t8 = tile + (8 * k8) * RSF + n;
            if (!f8) { u32x4 w; w.x = pk2(t8[0], t8[RSF]); w.y = pk2(t8[2 * RSF], t8[3 * RSF]); w.z = pk2(t8[4 * RSF], t8[5 * RSF]); w.w = pk2(t8[6 * RSF], t8[7 * RSF]);
                *(u32x4*)(dst + (size_t)(n0 + n) * 1024 + k0 + 8 * k8) = w; }
            else { u32x2 w; w.x = pk4_fp8(t8[0] * W8_SCALE, t8[RSF] * W8_SCALE, t8[2 * RSF] * W8_SCALE, t8[3 * RSF] * W8_SCALE); w.y = pk4_fp8(t8[4 * RSF] * W8_SCALE, t8[5 * RSF] * W8_SCALE, t8[6 * RSF] * W8_SCALE, t8[7 * RSF] * W8_SCALE);
                *(u32x2*)((unsigned char*)dst + (size_t)(n0 + n) * 1024 + k0 + 8 * k8) = w; } }
    }
    __syncthreads();
}

__device__ void p0_filter(const Frame& F) {
    LAS float* zf = (LAS float*)F.lds;
    LAS float* h1 = zf + 16 * 36;
    LAS float* h2 = h1 + 16 * 64;
    float* HRAW = (float*)(F.ws + WS_HRAW); float* SUMSQ = (float*)(F.ws + WS_SUMSQ);
    const float* fr = F.in[I_FREQ];
    for (int it = F.bid; it < 256; it += F.G) {
        const int t0 = it * 16;
        __syncthreads();
        for (int e = F.tid; e < 16 * 33; e += NTHR) { const int tt = e / 33, i = e % 33, t = t0 + tt; float v;
            if (i == 0) v = (float)((double)t / 4095.0);
            else { const int j = (i - 1) & 15; const double f = 1e-4 + (double)j * ((15.0 - 1e-4) / 15.0); double rev = (double)t * f / 4096.0; rev -= floor(rev);
                v = (i <= 16) ? __builtin_amdgcn_cosf((float)rev) : -__builtin_amdgcn_sinf((float)rev); }
            zf[tt * 36 + i] = v; }
        __syncthreads();
        for (int e = F.tid; e < 1024; e += NTHR) { const int tt = e >> 6, j = e & 63; float a = F.in[I_B1][j];
            for (int i = 0; i < 33; ++i) a += zf[tt * 36 + i] * F.in[I_W1][i * 64 + j];
            h1[tt * 64 + j] = sinf(fr[j] * a); }
        __syncthreads();
        for (int e = F.tid; e < 1024; e += NTHR) { const int tt = e >> 6, j = e & 63; float a = F.in[I_B2][j];
            for (int i = 0; i < 64; ++i) a += h1[tt * 64 + i] * F.in[I_W2][i * 64 + j];
            h2[tt * 64 + j] = sinf(fr[j] * a); }
        __syncthreads();
        float acc[16][4];
#pragma unroll
        for (int tt = 0; tt < 16; ++tt)
#pragma unroll
            for (int q = 0; q < 4; ++q) acc[tt][q] = 0.f;
        for (int k = 0; k < 64; ++k) { float w[4];
#pragma unroll
            for (int q = 0; q < 4; ++q) w[q] = F.in[I_W3][k * 2048 + q * 512 + F.tid];
#pragma unroll
            for (int tt = 0; tt < 16; ++tt) { const float hv = h2[tt * 64 + k];
#pragma unroll
                for (int q = 0; q < 4; ++q) acc[tt][q] += hv * w[q]; } }
#pragma unroll
        for (int q = 0; q < 4; ++q) { const int col = q * 512 + F.tid; const float dc = fabsf(F.in[I_DECAY][col]); float ss = 0.f;
#pragma unroll
            for (int tt = 0; tt < 16; ++tt) { const int t = t0 + tt; const float tn = (float)((double)t / 4095.0); const float v = acc[tt][q] * expf(-tn * dc);
                acc[tt][q] = v; if (!(col >= 1024 && t == 0)) ss += v * v; }
#pragma unroll
            for (int t4 = 0; t4 < 4; ++t4) *(f32x4*)(HRAW + (size_t)col * 4096 + t0 + 4 * t4) = (f32x4){acc[4 * t4][q], acc[4 * t4 + 1][q], acc[4 * t4 + 2][q], acc[4 * t4 + 3][q]};
            SUMSQ[(size_t)it * 2048 + col] = ss; }
    }
}

template <int MODE>
__device__ void norm_proj32(const Frame& F, const float* X, const float* nw, const float* Wsrc, int wld, bf16_t* XNout) {
    constexpr int ROWB = 2064;
    LAS unsigned char* thi = F.lds; LAS unsigned char* tlo = F.lds + 32 * ROWB;
    LAS float* part = (LAS float*)F.lds;
    LAS float* logit = (LAS float*)(F.lds + 32768);
    const int lane = F.lane, w = F.wave;
    bf16x8 Bhi[8], Blo[8];
    { const int c = lane & 31, hh = lane >> 5;
#pragma unroll
      for (int ks = 0; ks < 8; ++ks) { const int k0 = 128 * w + 16 * ks + 8 * hh;
#pragma unroll
        for (int j = 0; j < 8; ++j) { const float v = Wsrc[(size_t)(k0 + j) * wld + c]; const bf16_t h = f2bf(v); const bf16_t l = f2bf(v - bf2f(h)); Bhi[ks][j] = (short)h; Blo[ks][j] = (short)l; } } }
    f32x4 nwv[4];
#pragma unroll
    for (int q = 0; q < 4; ++q) nwv[q] = *(const f32x4*)(nw + 256 * q + 4 * lane);
    const int ngroups = T_ / 32, gpb = (ngroups + F.G - 1) / F.G;
    const int g_lo = F.bid * gpb, g_hi = (g_lo + gpb < ngroups) ? g_lo + gpb : ngroups;
    if (MODE == 1) { if (F.tid < 32) F.misc[MW_CNT + F.tid] = 0u; }
    __syncthreads();
    f32x4 xf[4][4]; u32x2 xh[4][4];
#define NP_ISSUE(GI) do { _Pragma("unroll") for (int i = 0; i < 4; ++i) { const size_t t = (size_t)(GI) * 32 + 4 * w + i; \
        _Pragma("unroll") for (int q = 0; q < 4; ++q) { if (MODE == 0) xf[i][q] = *(const f32x4*)(X + t * 1024 + 256 * q + 4 * lane); else xh[i][q] = *(const u32x2*)((const bf16_t*)X + t * 1024 + 256 * q + 4 * lane); } } } while (0)
    if (g_lo < g_hi) NP_ISSUE(g_lo);
    for (int gi = g_lo; gi < g_hi; ++gi) {
#pragma unroll
        for (int i = 0; i < 4; ++i) { const int tk = 4 * w + i; const size_t t = (size_t)gi * 32 + tk;
            f32x4 xv[4]; float ss = 0.f;
#pragma unroll
            for (int q = 0; q < 4; ++q) { if (MODE == 0) xv[q] = xf[i][q]; else { const u32x2 hb = xh[i][q]; xv[q] = (f32x4){bflo(hb.x), bfhi(hb.x), bflo(hb.y), bfhi(hb.y)}; }
                ss += xv[q][0] * xv[q][0] + xv[q][1] * xv[q][1] + xv[q][2] * xv[q][2] + xv[q][3] * xv[q][3]; }
            ss = wave_sum(ss); const float rstd = rsqrtf(ss * (1.f / 1024.f) + 1e-6f);
#pragma unroll
            for (int q = 0; q < 4; ++q) { const f32x4 v = xv[q] * rstd * nwv[q];
                bf16_t h[4], l[4];
#pragma unroll
                for (int e = 0; e < 4; ++e) { h[e] = f2bf(v[e]); l[e] = f2bf(v[e] - bf2f(h[e])); }
                u32x2 hw, lw; hw.x = (unsigned)h[0] | ((unsigned)h[1] << 16); hw.y = (unsigned)h[2] | ((unsigned)h[3] << 16); lw.x = (unsigned)l[0] | ((unsigned)l[1] << 16); lw.y = (unsigned)l[2] | ((unsigned)l[3] << 16);
                if (MODE == 0) { *(u32x2*)(XNout + t * 1024 + 256 * q + 4 * lane) = hw; *(unsigned*)(F.ws + WS_XN8 + t * 1024 + 256 * q + 4 * lane) = pk4_fp8(v[0], v[1], v[2], v[3]); } else *(unsigned*)((unsigned char*)XNout + t * 1024 + 256 * q + 4 * lane) = pk4_fp8(v[0], v[1], v[2], v[3]);
                *(LAS u32x2*)(thi + tk * ROWB + (256 * q + 4 * lane) * 2) = hw; *(LAS u32x2*)(tlo + tk * ROWB + (256 * q + 4 * lane) * 2) = lw; } }
        if (gi + 1 < g_hi) NP_ISSUE(gi + 1);
        __syncthreads();
        f32x16 acc;
#pragma unroll
        for (int i = 0; i < 16; ++i) acc[i] = 0.f;
        { const int r = lane & 31, hh = lane >> 5;
#pragma unroll
          for (int ks = 0; ks < 8; ++ks) { const int off = r * ROWB + (128 * w + 16 * ks + 8 * hh) * 2;
            const bf16x8 ah = *(const LAS bf16x8*)(thi + off), al = *(const LAS bf16x8*)(tlo + off);
            acc = __builtin_amdgcn_mfma_f32_32x32x16_bf16(ah, Bhi[ks], acc, 0, 0, 0);
            acc = __builtin_amdgcn_mfma_f32_32x32x16_bf16(al, Bhi[ks], acc, 0, 0, 0);
            acc = __builtin_amdgcn_mfma_f32_32x32x16_bf16(ah, Blo[ks], acc, 0, 0, 0); } }
        __syncthreads();
#pragma unroll
        for (int i = 0; i < 16; ++i) part[(w * 16 + i) * 64 + lane] = acc[i];
        __syncthreads();
        for (int o = F.tid; o < 1024; o += NTHR) { const int reg = o >> 6, ln = o & 63; float s = 0.f;
#pragma unroll
            for (int ww = 0; ww < 8; ++ww) s += part[(ww * 16 + reg) * 64 + ln];
            const int row = (reg & 3) + 8 * (reg >> 2) + 4 * (ln >> 5), e = ln & 31;
            if (MODE == 0) ((float*)(F.ws + WS_ALOW))[((size_t)gi * 32 + row) * 32 + e] = s; else logit[row * 33 + e] = s; }
        if (MODE == 1) {
            __syncthreads();
            if (F.tid < 32) { const int tk = F.tid; float v[32];
#pragma unroll
                for (int e = 0; e < 32; ++e) v[e] = logit[tk * 33 + e] + F.in[I_RB][e];
                unsigned taken = 0u; float tv[4]; int te[4];
#pragma unroll
                for (int k = 0; k < 4; ++k) { float best = -3.4e38f; int bi = 0;
#pragma unroll
                    for (int e = 0; e < 32; ++e) { const bool ok = !((taken >> e) & 1u) && (v[e] > best); best = ok ? v[e] : best; bi = ok ? e : bi; }
                    taken |= 1u << bi; tv[k] = best; te[k] = bi; }
                float ex[4], sum = 0.f;
#pragma unroll
                for (int k = 0; k < 4; ++k) { ex[k] = expf(tv[k] - tv[0]); sum += ex[k]; }
                const int tl = (gi - g_lo) * 32 + tk;
#pragma unroll
                for (int k = 0; k < 4; ++k) { const unsigned lp = atomicAdd((unsigned*)&F.misc[MW_CNT + te[k]], 1u);
                    F.misc[MW_SEL + (tl * 4 + k) * 3 + 0] = (unsigned)te[k]; F.misc[MW_SEL + (tl * 4 + k) * 3 + 1] = lp; F.misc[MW_SEL + (tl * 4 + k) * 3 + 2] = __float_as_uint(ex[k] / sum); } }
        }
        __syncthreads();
    }
    if (MODE == 1) {
        unsigned* gcount = F.ctl + CW_GCOUNT;
        if (F.tid < 32) F.misc[MW_BASE + F.tid] = __hip_atomic_fetch_add(gcount + F.tid, F.misc[MW_CNT + F.tid], __ATOMIC_RELAXED, __HIP_MEMORY_SCOPE_AGENT);
        __syncthreads();
        const int ntl = (g_hi - g_lo) * 32 * 4;
        for (int i = F.tid; i < ntl; i += NTHR) { const unsigned e = F.misc[MW_SEL + i * 3], lp = F.misc[MW_SEL + i * 3 + 1], wb = F.misc[MW_SEL + i * 3 + 2];
            const size_t gidx = (size_t)g_lo * 32 * 4 + i;
            const unsigned pos = F.misc[MW_BASE + e] + lp;
            ((int*)(F.ws + WS_EIDX))[gidx] = (int)e; ((int*)(F.ws + WS_POSE))[gidx] = (int)pos; ((unsigned*)(F.ws + WS_WGT))[gidx] = wb;
            ((int*)(F.ws + WS_LIST))[(size_t)e * T_ + pos] = (int)(gidx >> 2); }
        __syncthreads();
    }
}

#undef NP_ISSUE
__device__ void p1_rnorm(const Frame& F) {
    const float* SUMSQ = (const float*)(F.ws + WS_SUMSQ); float* RN = (float*)(F.ws + WS_RN);
    if (F.bid < 16 && F.tid < 64) { const int c = F.bid * 64 + F.tid; float sacc = 0.f;
        for (int i = 0; i < 256; ++i) sacc += SUMSQ[(size_t)i * 2048 + c] + SUMSQ[(size_t)i * 2048 + 1024 + c];
        RN[c] = rsqrtf(sacc + 1e-6f); }
}
__device__ void p2_gla_prep(const Frame& F) {
    LAS float* al = (LAS float*)F.lds; LAS float* tot = al + 64 * 32;
    const bf16_t* PQ = (const bf16_t*)(F.ws + WS_PQKV); const float* ALOW = (const float*)(F.ws + WS_ALOW);
    bf16_t* QT = (bf16_t*)(F.ws + WS_QT); bf16_t* KT = (bf16_t*)(F.ws + WS_KT); bf16_t* KE = (bf16_t*)(F.ws + WS_KE); float* DEC = (float*)(F.ws + WS_DEC);
    const int dk = F.tid & 127, tq = F.tid >> 7;
    const int pos = (dk & ~15) | swap23(dk & 15);
    for (int it = F.bid; it < 2048; it += F.G) {
        const int h = it & 3, n = (it >> 2) & 63, b = it >> 8; const size_t grow0 = (size_t)b * L_ + 64 * n;
        __syncthreads();
        { const int row = F.tid >> 3, c4 = (F.tid & 7) * 4; *(LAS f32x4*)(al + row * 32 + c4) = *(const f32x4*)(ALOW + (grow0 + row) * 32 + c4); }
        bf16_t qraw[16], kraw[16];
#pragma unroll
        for (int ii = 0; ii < 16; ++ii) { const size_t g = (grow0 + tq * 16 + ii) * 2048; qraw[ii] = PQ[g + h * 128 + dk]; kraw[ii] = PQ[g + 512 + h * 128 + dk]; }
        __syncthreads();
#pragma unroll
        for (int d = 0; d < 2; ++d) {
            float c[16];
            { float w2r[16]; const float gb = F.in[I_GB][d * 512 + h * 128 + dk];
#pragma unroll
              for (int r = 0; r < 16; ++r) w2r[r] = F.in[I_GW2][(d * 16 + r) * 512 + h * 128 + dk];
#pragma unroll
              for (int ii = 0; ii < 16; ii += 2) { const int i = tq * 16 + ii; f32x2 l2 = (f32x2){gb, gb};
#pragma unroll
                for (int r4 = 0; r4 < 16; r4 += 4) { const f32x4 a0 = *(const LAS f32x4*)(al + i * 32 + d * 16 + r4), a1 = *(const LAS f32x4*)(al + (i + 1) * 32 + d * 16 + r4);
#pragma unroll
                    for (int e = 0; e < 4; ++e) l2 = __builtin_elementwise_fma((f32x2){a0[e], a1[e]}, (f32x2){w2r[r4 + e], w2r[r4 + e]}, l2); }
                c[ii] = (fminf(l2[0], 0.f) - __logf(1.f + __expf(-fabsf(l2[0])))) * (1.f / 16.f); c[ii + 1] = (fminf(l2[1], 0.f) - __logf(1.f + __expf(-fabsf(l2[1])))) * (1.f / 16.f); } }
            if (d == 0) {
#pragma unroll
                for (int ii = 1; ii < 16; ++ii) c[ii] += c[ii - 1];
            } else {
#pragma unroll
                for (int ii = 14; ii >= 0; --ii) c[ii] += c[ii + 1];
            }
            __syncthreads();
            tot[tq * 128 + dk] = d == 0 ? c[15] : c[0];
            __syncthreads();
            float off = 0.f, total = 0.f;
#pragma unroll
            for (int t2 = 0; t2 < 4; ++t2) { const float a = tot[t2 * 128 + dk]; total += a; if (d == 0 ? (t2 < tq) : (t2 > tq)) off += a; }
            const size_t cb = (size_t)(((d * 8 + b) * 4 + h) * 64 + n);
            bf16_t* qd = QT + (cb * 64 + tq * 16) * 128 + pos; bf16_t* kd = KT + (cb * 64 + tq * 16) * 128 + pos;
            float ke[16];
            const float etot = __expf(total);
#pragma unroll
            for (int ii = 0; ii < 16; ++ii) { const float qv = bf2f(qraw[ii]), kv = bf2f(kraw[ii]); const float bb = c[ii] + off; const float kdec = kv * __expf(-bb);
                qd[ii * 128] = f2bf(qv * __expf(bb)); kd[ii * 128] = f2bf(kdec); ke[ii] = kdec * etot;
                if ((ii & 3) == 3) __builtin_amdgcn_sched_barrier(0); }
            { u32x4 w0, w1;
              w0.x = pk2(ke[0], ke[1]); w0.y = pk2(ke[2], ke[3]); w0.z = pk2(ke[8], ke[9]); w0.w = pk2(ke[10], ke[11]);
              w1.x = pk2(ke[4], ke[5]); w1.y = pk2(ke[6], ke[7]); w1.z = pk2(ke[12], ke[13]); w1.w = pk2(ke[14], ke[15]);
              u32x4* dd = (u32x4*)(KE + (cb * 128 + dk) * 64 + 16 * tq); dd[0] = w0; dd[1] = w1; }
            if (tq == 0) DEC[cb * 128 + dk] = etot;
            __builtin_amdgcn_sched_barrier(0);
        }
    }
}

constexpr int GS_QT = 0, GS_KT = 16384, GS_KE = 32768, GS_DEC = 49152, GS_SLOT = 50176, GS_V = 2 * GS_SLOT, GS_O = GS_V + 32768;
__device__ __forceinline__ void gla_dma(const Frame& F, LAS unsigned char* slot, __amdgpu_buffer_rsrc_t rR1, unsigned soffR1, const unsigned (&goff)[6], __amdgpu_buffer_rsrc_t rDEC, unsigned soffDEC, __amdgpu_buffer_rsrc_t rVT, unsigned soffVT, const unsigned (&voff)[4]) {
#pragma unroll
    for (int j = 0; j < 4; ++j) __builtin_amdgcn_raw_ptr_buffer_load_lds(rVT, (LAS void*)(F.lds + GS_V + F.wave * 4096 + j * 1024), 16, voff[j], (int)soffVT, 0, 0);
#pragma unroll
    for (int j = 0; j < 6; ++j) __builtin_amdgcn_raw_ptr_buffer_load_lds(rR1, (LAS void*)(slot + (F.wave * 6 + j) * 1024), 16, goff[j], (int)soffR1, 0, 0);
    if (F.wave == 0) __builtin_amdgcn_raw_ptr_buffer_load_lds(rDEC, (LAS void*)(slot + GS_DEC), 16, 16u * (unsigned)F.lane, (int)soffDEC, 0, 0);
}
__device__ void p3_gla_scan(const Frame& F) {
    if (F.bid >= 64) return;
    const int dir = F.bid & 1, h = (F.bid >> 1) & 3, b = F.bid >> 3, vb = F.wave, l31 = F.lane & 31, hh = F.lane >> 5;
    const __amdgpu_buffer_rsrc_t rR1 = __builtin_amdgcn_make_buffer_rsrc((void*)(F.ws + WS_R1), 0, 0x7FFFFFFF, 0x00020000), rVT = __builtin_amdgcn_make_buffer_rsrc((void*)(F.ws + WS_PQKV), 0, 0x7FFFFFFF, 0x00020000),
                                 rDEC = __builtin_amdgcn_make_buffer_rsrc((void*)(F.ws + WS_DEC), 0, 0x7FFFFFFF, 0x00020000);
    bf16_t* O = (bf16_t*)(F.ws + (dir ? WS_OB : WS_OF));
    unsigned goff[6], voff[4];
#pragma unroll
    for (int j = 0; j < 6; ++j) { const int pi = F.wave * 6 + j, arr = pi >> 4, p = pi & 15, l = F.lane;
        if (arr < 2) { const int row = 4 * p + (l >> 4), cpos = l & 15; goff[j] = (unsigned)arr * (64u << 20) + (unsigned)(row * 256 + 16 * (cpos ^ (row & 15))); }
        else { const int row = 8 * p + (l >> 3), cpos = l & 7; goff[j] = (128u << 20) + (unsigned)(row * 128 + 16 * (cpos ^ ((row >> 1) & 7))); } }
#pragma unroll
    for (int j = 0; j < 4; ++j) voff[j] = (unsigned)((16 * j + (F.lane >> 2)) * 4096 + (1024 + h * 256 + 32 * vb) * 2 + 16 * (F.lane & 3));
    f32x16 S[4];
#pragma unroll
    for (int kb = 0; kb < 4; ++kb)
#pragma unroll
        for (int i = 0; i < 16; ++i) S[kb][i] = 0.f;
    const size_t cbase = (size_t)(((dir * 8 + b) * 4 + h) * 64);
    { const int n0 = dir ? 63 : 0; const size_t cb = cbase + n0;
      gla_dma(F, F.lds, rR1, (unsigned)cb * 16384u, goff, rDEC, (unsigned)cb * 512u, rVT, (unsigned)(b * L_ + 64 * n0) * 4096u, voff); }
    asm volatile("s_waitcnt vmcnt(0)" ::: "memory");
    __builtin_amdgcn_s_barrier();
    const int r15 = l31 & 15;
    const LAS unsigned char* vcol = F.lds + GS_V + F.wave * 4096 + l31 * 2;
    const int vsw = (l31 >> 1) & 7;
    for (int cs = 0; cs < 64; ++cs) {
        const int n = dir ? 63 - cs : cs;
        bf16x8 vf[4];
#pragma unroll
        for (int s4 = 0; s4 < 4; ++s4) { unsigned short e[8];
#pragma unroll
            for (int i = 0; i < 4; ++i) { e[i] = *(const LAS bf16_t*)(vcol + (16 * s4 + 4 * hh + i) * 64); e[4 + i] = *(const LAS bf16_t*)(vcol + (16 * s4 + 8 + 4 * hh + i) * 64); }
            u32x4 w; w.x = e[0] | ((unsigned)e[1] << 16); w.y = e[2] | ((unsigned)e[3] << 16); w.z = e[4] | ((unsigned)e[5] << 16); w.w = e[6] | ((unsigned)e[7] << 16);
            vf[s4] = __builtin_bit_cast(bf16x8, w); }
        asm volatile("s_waitcnt lgkmcnt(0)" ::: "memory");
        __builtin_amdgcn_sched_barrier(0);
        if (cs + 1 < 64) { const int n1 = dir ? 62 - cs : cs + 1; const size_t cb = cbase + n1;
            gla_dma(F, F.lds + ((cs + 1) & 1) * GS_SLOT, rR1, (unsigned)cb * 16384u, goff, rDEC, (unsigned)cb * 512u, rVT, (unsigned)(b * L_ + 64 * n1) * 4096u, voff); }
        __builtin_amdgcn_sched_barrier(0);
        const LAS unsigned char* sl = F.lds + (cs & 1) * GS_SLOT;
        const LAS unsigned char* qrow = sl + GS_QT + l31 * 256; const LAS unsigned char* krow = sl + GS_KT + l31 * 256;
#pragma unroll
        for (int ib = 0; ib < 2; ++ib) {
            const bool has_off = dir ? (ib == 0) : (ib == 1);
            const int jo = dir ? 1 : 0;
            f32x16 sa, sb;
#pragma unroll
            for (int i = 0; i < 16; ++i) { sa[i] = 0.f; sb[i] = 0.f; }
            bf16x8 qn = *(const LAS bf16x8*)(qrow + ib * 8192 + 16 * (hh ^ r15)), kdn = *(const LAS bf16x8*)(krow + ib * 8192 + 16 * (hh ^ r15)), kon = kdn;
            if (has_off) kon = *(const LAS bf16x8*)(krow + jo * 8192 + 16 * (hh ^ r15));
#pragma unroll
            for (int s8 = 0; s8 < 8; ++s8) { const bf16x8 q = qn, kd = kdn, ko = kon;
                if (s8 < 7) { const int sw = 16 * ((2 * s8 + 2 + hh) ^ r15);
                    qn = *(const LAS bf16x8*)(qrow + ib * 8192 + sw); kdn = *(const LAS bf16x8*)(krow + ib * 8192 + sw);
                    if (has_off) kon = *(const LAS bf16x8*)(krow + jo * 8192 + sw); }
                sa = __builtin_amdgcn_mfma_f32_32x32x16_bf16(kd, q, sa, 0, 0, 0);
                if (has_off) sb = __builtin_amdgcn_mfma_f32_32x32x16_bf16(ko, q, sb, 0, 0, 0);
                __builtin_amdgcn_sched_barrier(0); }
            bf16x8 q0n = *(const LAS bf16x8*)(qrow + ib * 8192 + 16 * (hh ^ r15)), q1n = *(const LAS bf16x8*)(qrow + ib * 8192 + 16 * ((2 + hh) ^ r15));
#pragma unroll
            for (int reg = 0; reg < 16; ++reg) { const int jl = (reg & 3) + 8 * (reg >> 2) + 4 * hh; const bool keep = (dir == 0) ? (jl <= l31) : (jl > l31); sa[reg] = keep ? sa[reg] : 0.f; }
            f32x16 o;
#pragma unroll
            for (int i = 0; i < 16; ++i) o[i] = 0.f;
            o = __builtin_amdgcn_mfma_f32_32x32x16_bf16(pack8(sa, 0), vf[2 * ib], o, 0, 0, 0);
            o = __builtin_amdgcn_mfma_f32_32x32x16_bf16(pack8(sa, 8), vf[2 * ib + 1], o, 0, 0, 0);
            if (has_off) {
                const bf16x8 vo0 = dir ? vf[2] : vf[0], vo1 = dir ? vf[3] : vf[1];
                o = __builtin_amdgcn_mfma_f32_32x32x16_bf16(pack8(sb, 0), vo0, o, 0, 0, 0);
                o = __builtin_amdgcn_mfma_f32_32x32x16_bf16(pack8(sb, 8), vo1, o, 0, 0, 0); }
            __builtin_amdgcn_sched_barrier(0);
#pragma unroll
            for (int kb = 0; kb < 4; ++kb) { const bf16x8 q0 = q0n, q1 = q1n;
                if (kb < 3) { q0n = *(const LAS bf16x8*)(qrow + ib * 8192 + 16 * ((4 * kb + 4 + hh) ^ r15)); q1n = *(const LAS bf16x8*)(qrow + ib * 8192 + 16 * ((4 * kb + 6 + hh) ^ r15)); }
                o = __builtin_amdgcn_mfma_f32_32x32x16_bf16(q0, pack8(S[kb], 0), o, 0, 0, 0);
                o = __builtin_amdgcn_mfma_f32_32x32x16_bf16(q1, pack8(S[kb], 8), o, 0, 0, 0);
                __builtin_amdgcn_sched_barrier(0);
            }
            { LAS unsigned char* ost = F.lds + GS_O + F.wave * 2048;
#pragma unroll
              for (int reg = 0; reg < 16; ++reg) *(LAS bf16_t*)(ost + ((reg & 3) + 8 * (reg >> 2) + 4 * hh) * 64 + l31 * 2) = f2bf(o[reg]);
#pragma unroll
              for (int j = 0; j < 2; ++j) { const int pc = F.lane + 64 * j, row = pc >> 2, part = pc & 3;
                  *(u32x4*)(O + ((size_t)b * L_ + 64 * n + 32 * ib + row) * 1024 + h * 256 + 32 * vb + 8 * part) = *(const LAS u32x4*)(ost + row * 64 + part * 16); } }
            __builtin_amdgcn_sched_barrier(0);
        }
        {
          const LAS unsigned char* kerow = sl + GS_KE + l31 * 128; const LAS unsigned char* decp = sl + GS_DEC + 16 * hh;
          bf16x8 ken = *(const LAS bf16x8*)(kerow + 16 * (hh ^ vsw));
          f32x4 dn[4];
#pragma unroll
          for (int g = 0; g < 4; ++g) dn[g] = *(const LAS f32x4*)(decp + 32 * g);
#pragma unroll
          for (int kb = 0; kb < 4; ++kb) {
#pragma unroll
            for (int g = 0; g < 4; ++g)
#pragma unroll
                for (int e = 0; e < 4; ++e) S[kb][4 * g + e] *= dn[g][e];
            if (kb < 3) {
#pragma unroll
                for (int g = 0; g < 4; ++g) dn[g] = *(const LAS f32x4*)(decp + 128 * (kb + 1) + 32 * g); }
#pragma unroll
            for (int s4 = 0; s4 < 4; ++s4) { const bf16x8 kef = ken; const int st = kb * 4 + s4 + 1;
                if (st < 16) ken = *(const LAS bf16x8*)(kerow + (st >> 2) * 4096 + 16 * ((2 * (st & 3) + hh) ^ vsw));
                S[kb] = __builtin_amdgcn_mfma_f32_32x32x16_bf16(kef, vf[s4], S[kb], 0, 0, 0);
                __builtin_amdgcn_sched_barrier(0); }
          }
        }
        asm volatile("s_waitcnt vmcnt(4)\n\ts_waitcnt lgkmcnt(0)" ::: "memory");
        __builtin_amdgcn_s_barrier();
    }
    asm volatile("s_waitcnt vmcnt(0)" ::: "memory");
    __syncthreads();
}

__device__ void p4_conv_mfma(const Frame& F, int qsel) {
    constexpr int RS = 10560;
    LAS unsigned char* Rl = F.lds; LAS unsigned char* Zl = F.lds + 65536;
    const float* HRAWT = (const float*)(F.ws + WS_HRAW); const float* RN = (const float*)(F.ws + WS_RN); const bf16_t* XT = (const bf16_t*)(F.ws + WS_PHY); bf16_t* YT = (bf16_t*)(F.ws + WS_YT);
    const int lane = F.lane, g = F.wave >> 2, qp = F.wave & 3, q1 = 2 * qp + 1, cn = lane & 31, T1l = cn >> 3, b = cn & 7, hh = lane >> 5, r = lane & 31;
    __syncthreads();
    const int base_b = b * RS + 272 * T1l + 16 * hh;
    const int base_a = 2 * (4096 - 128 * (4 * q1 + 3) + 8 * hh - 4 * r);
    for (;;) {
        __syncthreads();
        if (F.tid == 0) F.misc[MW_Q] = __hip_atomic_fetch_add(F.ctl + CW_CONVQ + 64 * qsel, 1u, __ATOMIC_RELAXED, __HIP_MEMORY_SCOPE_AGENT);
        __syncthreads();
        const int cq = (int)F.misc[MW_Q];
        if (cq >= (PROBE_PHASE == 32 ? 2048 : 1024)) break;
        const int c = cq & 1023;
        for (int ch = F.tid; ch < 768; ch += NTHR) { const int bb = ch / 96, k = ch % 96, idx8 = k < 48 ? 8 * k : 4480 + 8 * (k - 48);
            *(LAS u32x4*)(Zl + bb * RS + 2 * idx8 + 16 * (idx8 >> 7)) = (u32x4){0u, 0u, 0u, 0u}; }
        { int ln; asm volatile("v_mbcnt_lo_u32_b32 %0, -1, 0\n\tv_mbcnt_hi_u32_b32 %0, -1, %0" : "=v"(ln)); const int tq = F.wave * 64 + ln;
          const float* gfw = HRAWT + (size_t)c * 4096; const float* gbw = HRAWT + (size_t)(1024 + c) * 4096; const float rn = RN[c], bi = F.in[I_HBIAS][c];
          f32x4 vf[2], vb[2];
#pragma unroll
          for (int k = 0; k < 2; ++k) { vf[k] = *(const f32x4*)(gfw + (tq + NTHR * k) * 4); vb[k] = *(const f32x4*)(gbw + (tq + NTHR * k) * 4); }
          { const bf16_t* x1p = XT + (size_t)c * T_; const bf16_t* vvp = XT + (size_t)(1024 + c) * T_;
            const float* cw = F.in[I_CW]; const float* cb = F.in[I_CB];
            const float wa0 = cw[1024 + c], wa1 = cw[3072 + 1024 + c], wa2 = cw[2 * 3072 + 1024 + c], ba = cb[1024 + c];
            const float wv0 = cw[2048 + c], wv1 = cw[3072 + 2048 + c], wv2 = cw[2 * 3072 + 2048 + c], bv = cb[2048 + c];
            u32x4 xr[8], vr[8]; bf16_t exl[8], exr[8], evl[8], evr[8];
#pragma unroll
            for (int k = 0; k < 8; ++k) { const int chunk = tq + NTHR * k, t8 = (chunk & 511) * 8; const size_t g0 = (size_t)(chunk >> 9) * 4096 + t8;
                xr[k] = *(const u32x4*)(x1p + g0); vr[k] = *(const u32x4*)(vvp + g0);
                exl[k] = 0; exr[k] = 0; evl[k] = 0; evr[k] = 0;
                if (ln == 0 && t8 > 0) { exl[k] = x1p[g0 - 1]; evl[k] = vvp[g0 - 1]; }
                if (ln == 63 && t8 + 8 < 4096) { exr[k] = x1p[g0 + 8]; evr[k] = vvp[g0 + 8]; } }
#pragma unroll
            for (int k = 0; k < 8; ++k) { const int chunk = tq + NTHR * k, bb = chunk >> 9, idx = (chunk & 511) * 8 + 384;
                const unsigned xlu = __shfl_up(xr[k].w, 1), xru = __shfl_down(xr[k].x, 1), vlu = __shfl_up(vr[k].w, 1), vru = __shfl_down(vr[k].x, 1);
                float xe[10], ve[10];
                xe[0] = ln == 0 ? bf2f(exl[k]) : bfhi(xlu); xe[9] = ln == 63 ? bf2f(exr[k]) : bflo(xru); ve[0] = ln == 0 ? bf2f(evl[k]) : bfhi(vlu); ve[9] = ln == 63 ? bf2f(evr[k]) : bflo(vru);
                xe[1] = bflo(xr[k].x); xe[2] = bfhi(xr[k].x); xe[3] = bflo(xr[k].y); xe[4] = bfhi(xr[k].y); xe[5] = bflo(xr[k].z); xe[6] = bfhi(xr[k].z); xe[7] = bflo(xr[k].w); xe[8] = bfhi(xr[k].w);
                ve[1] = bflo(vr[k].x); ve[2] = bfhi(vr[k].x); ve[3] = bflo(vr[k].y); ve[4] = bfhi(vr[k].y); ve[5] = bflo(vr[k].z); ve[6] = bfhi(vr[k].z); ve[7] = bflo(vr[k].w); ve[8] = bfhi(vr[k].w);
                float zz[8];
#pragma unroll
                for (int e = 0; e < 8; ++e) zz[e] = (wv0 * ve[e] + wv1 * ve[e + 1] + wv2 * ve[e + 2] + bv) * (wa0 * xe[e] + wa1 * xe[e + 1] + wa2 * xe[e + 2] + ba);
                u32x4 zw; zw.x = pk2(zz[0], zz[1]); zw.y = pk2(zz[2], zz[3]); zw.z = pk2(zz[4], zz[5]); zw.w = pk2(zz[6], zz[7]);
                *(LAS u32x4*)(Zl + bb * RS + 2 * idx + 16 * (idx >> 7)) = zw; } }
#pragma unroll
          for (int k = 0; k < 2; ++k)
#pragma unroll
            for (int e = 0; e < 4; ++e) { const int d = (tq + NTHR * k) * 4 + e; float v = vf[k][e] * rn; if (d == 0) v += bi; const bf16_t hv = f2bf(v), hb = f2bf(vb[k][e] * rn);
#pragma unroll
                for (int m = 0; m < 4; ++m) { *(LAS bf16_t*)(Rl + m * 16384 + 2 * (m + 4096 - d)) = hv;
                    const int ib = m + 4096 + d; if (d >= 1 && ib < 8192) *(LAS bf16_t*)(Rl + m * 16384 + 2 * ib) = hb; } } }
        __syncthreads();
        f32x16 acc0[4], acc1[4];
#pragma unroll
        for (int m = 0; m < 4; ++m)
#pragma unroll
            for (int i = 0; i < 16; ++i) { acc0[m][i] = 0.f; acc1[m][i] = 0.f; }
#define CONV_STEPS(JLO, JHI, DO0, DO1) do { const LAS unsigned char* pa = Rl + base_a + 32 * (JLO); const LAS unsigned char* pb1 = Zl + base_b + 272 * ((JLO) >> 3); \
        for (int jo = (JLO); jo < (JHI); jo += 8) { \
            _Pragma("unroll") for (int ki = 0; ki < 8; ++ki) { \
                bf16x8 bf1, bf0; if (DO1) bf1 = *(const LAS bf16x8*)(pb1 + 32 * ki); if (DO0) bf0 = *(const LAS bf16x8*)(pb1 - 1088 + 32 * ki); \
                _Pragma("unroll") for (int m = 0; m < 4; ++m) { const u32x2 lo = *(const LAS u32x2*)(pa + m * 16384 + 32 * ki), hi = *(const LAS u32x2*)(pa + m * 16384 + 32 * ki + 8); \
                    u32x4 av; av.x = lo.x; av.y = lo.y; av.z = hi.x; av.w = hi.y; const bf16x8 af = __builtin_bit_cast(bf16x8, av); \
                    if (DO1) acc1[m] = __builtin_amdgcn_mfma_f32_32x32x16_bf16(af, bf1, acc1[m], 0, 0, 0); \
                    if (DO0) acc0[m] = __builtin_amdgcn_mfma_f32_32x32x16_bf16(af, bf0, acc0[m], 0, 0, 0); } } \
            pa += 256; pb1 += 272; } } while (0)
        if (g == 0) { CONV_STEPS(0, 32, false, true); CONV_STEPS(32, 160, true, true); }
        else        { CONV_STEPS(160, 280, true, true); CONV_STEPS(280, 312, true, false); }
#undef CONV_STEPS
        __syncthreads();
        { LAS unsigned char* part = F.lds + qp * 32768 + lane * 16;
          if (g == 1) {
#pragma unroll
            for (int m = 0; m < 4; ++m)
#pragma unroll
                for (int v4 = 0; v4 < 4; ++v4) { *(LAS f32x4*)(part + ((0 * 4 + m) * 4 + v4) * 1024) = (f32x4){acc0[m][4 * v4], acc0[m][4 * v4 + 1], acc0[m][4 * v4 + 2], acc0[m][4 * v4 + 3]};
                    *(LAS f32x4*)(part + ((1 * 4 + m) * 4 + v4) * 1024) = (f32x4){acc1[m][4 * v4], acc1[m][4 * v4 + 1], acc1[m][4 * v4 + 2], acc1[m][4 * v4 + 3]}; } }
          __syncthreads();
          if (g == 0) {
#pragma unroll
            for (int m = 0; m < 4; ++m)
#pragma unroll
                for (int v4 = 0; v4 < 4; ++v4) { const f32x4 p0 = *(const LAS f32x4*)(part + ((0 * 4 + m) * 4 + v4) * 1024), p1 = *(const LAS f32x4*)(part + ((1 * 4 + m) * 4 + v4) * 1024);
#pragma unroll
                    for (int e = 0; e < 4; ++e) { acc0[m][4 * v4 + e] += p0[e]; acc1[m][4 * v4 + e] += p1[e]; } } }
          __syncthreads(); }
        if (g == 0) {
#pragma unroll
            for (int reg = 0; reg < 16; ++reg) { const int rp = (reg & 3) + 8 * (reg >> 2) + 4 * hh;
                { const int idx = 128 * (4 * (q1 - 1) + T1l) + 4 * rp + 384; u32x2 wv; wv.x = pk2(acc0[0][reg], acc0[1][reg]); wv.y = pk2(acc0[2][reg], acc0[3][reg]); *(LAS u32x2*)(Zl + b * RS + 2 * idx + 16 * (idx >> 7)) = wv; }
                { const int idx = 128 * (4 * q1 + T1l) + 4 * rp + 384; u32x2 wv; wv.x = pk2(acc1[0][reg], acc1[1][reg]); wv.y = pk2(acc1[2][reg], acc1[3][reg]); *(LAS u32x2*)(Zl + b * RS + 2 * idx + 16 * (idx >> 7)) = wv; } } }
        __syncthreads();
#pragma unroll
        for (int k = 0; k < 8; ++k) { const int chunk = F.tid + NTHR * k, bb = chunk >> 9, idx = (chunk & 511) * 8 + 384;
            *(u32x4*)(YT + ((size_t)c * 8 + bb) * 4096 + (chunk & 511) * 8) = *(const LAS u32x4*)(Zl + bb * RS + 2 * idx + 16 * (idx >> 7)); }
    }
    __syncthreads();
}

__device__ void p5_finish(const Frame& F) {
    const bf16_t* OF = (const bf16_t*)(F.ws + WS_OF); const bf16_t* OB = (const bf16_t*)(F.ws + WS_OB); const bf16_t* PR = (const bf16_t*)(F.ws + WS_PR);
    bf16_t* OG = (bf16_t*)(F.ws + WS_OGLA);
    const int lane = F.lane;
    const f32x4 gn = *(const f32x4*)(F.in[I_GNW] + 4 * lane);
    for (int row0 = (F.bid * 8 + F.wave) * 4; row0 < T_ * 4; row0 += F.G * 8 * 4) {
        u32x2 a[4], b[4], r[4];
#pragma unroll
        for (int j = 0; j < 4; ++j) { const size_t o = (size_t)(row0 + j) * 256 + 4 * lane; a[j] = *(const u32x2*)(OF + o); b[j] = *(const u32x2*)(OB + o); r[j] = *(const u32x2*)(PR + o); }
#pragma unroll
        for (int j = 0; j < 4; ++j) { const size_t o = (size_t)(row0 + j) * 256 + 4 * lane;
            float v[4] = {bflo(a[j].x) + bflo(b[j].x), bfhi(a[j].x) + bfhi(b[j].x), bflo(a[j].y) + bflo(b[j].y), bfhi(a[j].y) + bfhi(b[j].y)};
            float ss = wave_sum(v[0] * v[0] + v[1] * v[1] + v[2] * v[2] + v[3] * v[3]);
            const float rstd = rsqrtf(ss * (1.f / 256.f) + 1e-6f);
            const float rr[4] = {bflo(r[j].x), bfhi(r[j].x), bflo(r[j].y), bfhi(r[j].y)};
            float ov[4];
#pragma unroll
            for (int e = 0; e < 4; ++e) { const float on = v[e] * rstd * gn[e]; ov[e] = on * (rr[e] * sigmoidf_(rr[e])); }
            u32x2 w; w.x = pk2(ov[0], ov[1]); w.y = pk2(ov[2], ov[3]); *(u32x2*)(OG + o) = w; }
    }
    { constexpr int RSZ = 2052; LAS unsigned char* zt = F.lds;
      const bf16_t* YT = (const bf16_t*)(F.ws + WS_YT); const bf16_t* X0C = (const bf16_t*)(F.ws + WS_X0C); bf16_t* OH = (bf16_t*)(F.ws + WS_OHY);
      for (int it = F.bid; it < T_ / 64; it += F.G) {
        const int bq = (it * 64) >> 12, tq0 = (it * 64) & 4095;
        __syncthreads();
        for (int o = F.tid; o < 8192; o += NTHR) { const int part = (o >> 3) & 7, c = (o & 7) + 8 * (o >> 6);
            const u32x4 wv = *(const u32x4*)(YT + ((size_t)c * 8 + bq) * 4096 + tq0 + 8 * part);
            const unsigned ww[4] = {wv.x, wv.y, wv.z, wv.w};
#pragma unroll
            for (int k = 0; k < 8; ++k) *(LAS bf16_t*)(zt + (8 * part + k) * RSZ + c * 2) = (bf16_t)((k & 1) ? (ww[k >> 1] >> 16) : (ww[k >> 1] & 0xffffu)); }
        __syncthreads();
        for (int o = F.tid; o < 64 * 256; o += NTHR) { const int tl = o >> 8, c0 = (o & 255) * 4; const size_t t = (size_t)it * 64 + tl;
            const LAS unsigned* zp = (const LAS unsigned*)(zt + tl * RSZ + c0 * 2); const unsigned y0 = zp[0], y1 = zp[1];
            const int tt = (int)(t & 4095); u32x2 xp, xn; xp.x = 0u; xp.y = 0u; xn = xp;
            const u32x2 xc = *(const u32x2*)(X0C + t * 1024 + c0); if (tt > 0) xp = *(const u32x2*)(X0C + (t - 1) * 1024 + c0); if (tt < 4095) xn = *(const u32x2*)(X0C + (t + 1) * 1024 + c0);
            const f32x4 w0 = *(const f32x4*)(F.in[I_CW] + c0), w1 = *(const f32x4*)(F.in[I_CW] + 3072 + c0), w2 = *(const f32x4*)(F.in[I_CW] + 6144 + c0), bz = *(const f32x4*)(F.in[I_CB] + c0);
            const float u0 = w0[0] * bflo(xp.x) + w1[0] * bflo(xc.x) + w2[0] * bflo(xn.x) + bz[0], u1 = w0[1] * bfhi(xp.x) + w1[1] * bfhi(xc.x) + w2[1] * bfhi(xn.x) + bz[1];
            const float u2 = w0[2] * bflo(xp.y) + w1[2] * bflo(xc.y) + w2[2] * bflo(xn.y) + bz[2], u3 = w0[3] * bfhi(xp.y) + w1[3] * bfhi(xc.y) + w2[3] * bfhi(xn.y) + bz[3];
            u32x2 wv; wv.x = pk2(bflo(y0) * u0, bfhi(y0) * u1); wv.y = pk2(bflo(y1) * u2, bfhi(y1) * u3);
            *(u32x2*)(OH + t * 1024 + c0) = wv; }
      }
      __syncthreads(); }
}

__device__ void moe_offsets(const Frame& F) {
    __syncthreads();
    if (F.tid == 0) { unsigned rb = 0, rt = 0; LAS unsigned char* te = (LAS unsigned char*)(F.misc + MW_TILE);
        for (int e = 0; e < 32; ++e) { const unsigned c = __hip_atomic_load(F.ctl + CW_GCOUNT + e, __ATOMIC_RELAXED, __HIP_MEMORY_SCOPE_AGENT); const unsigned nt = (c + 255u) >> 8;
            F.misc[MW_ROWB + e] = rb; for (unsigned i = 0; i < nt; ++i) te[rt + i] = (unsigned char)e; rt += nt; rb += nt * 256u; }
        F.misc[MW_ROWB + 32] = rb; F.misc[MW_RT] = rt; }
    __syncthreads();
}
constexpr int GT_TAB = 131072, GT_SLOT = 131072 + 17 * 1024;
__device__ void moe_gather_tables(const Frame& F, int nN) {
    LAS int* tab = (LAS int*)(F.lds + GT_TAB); LAS unsigned char* slot = F.lds + GT_SLOT; LAS int* pmof = (LAS int*)(F.lds + GT_SLOT + 544);
    const int RT = (int)F.misc[MW_RT];
    for (int i = F.tid; i < 544; i += NTHR) slot[i] = 0xFF;
    __syncthreads();
    if (F.tid == 0) { int ns = 0; const int nwg = RT * nN;
        for (int i = 0; ; ++i) { const long Lq = (long)i * F.G + F.bid; if (Lq >= nwg) break; int pm, pn; pg8::tile_of((int)Lq, RT, nN, pm, pn); if (slot[pm] == 0xFF) { const int sl = ns < 16 ? ns : 16; slot[pm] = (unsigned char)sl; pmof[sl] = pm; ++ns; } }
        F.misc[MW_Q] = (unsigned)(ns < 17 ? ns : 17); }
    __syncthreads();
    const int ns = (int)F.misc[MW_Q]; const int* LIST = (const int*)(F.ws + WS_LIST); const LAS unsigned char* te = (const LAS unsigned char*)(F.misc + MW_TILE);
    for (int i = F.tid; i < ns * 256; i += NTHR) { const int sl = i >> 8, r = i & 255, pm = pmof[sl], e = te[pm];
        const int pos = pm * 256 + r - (int)F.misc[MW_ROWB + e];
        const int cnt = (int)__hip_atomic_load(F.ctl + CW_GCOUNT + e, __ATOMIC_RELAXED, __HIP_MEMORY_SCOPE_AGENT);
        tab[i] = pos < cnt ? LIST[(size_t)e * T_ + pos] : 0; }
    __syncthreads();
}

__device__ void p12_combine(const Frame& F) {
    const unsigned char* OUTP = F.ws + WS_OUTP;                       const int* EIDX = (const int*)(F.ws + WS_EIDX); const int* POSE = (const int*)(F.ws + WS_POSE); const float* WGT = (const float*)(F.ws + WS_WGT);
    const int lane = F.lane;
    f32x4 nf[4];
#pragma unroll
    for (int q = 0; q < 4; ++q) nf[q] = *(const f32x4*)(F.in[I_NFW] + 256 * q + 4 * lane);
    for (int t = F.bid * 8 + F.wave; t < T_; t += F.G * 8) {
        f32x4 hv[4];
#pragma unroll
        for (int q = 0; q < 4; ++q) { const u32x2 hb = *(const u32x2*)((const bf16_t*)(F.ws + WS_H) + (size_t)t * 1024 + 256 * q + 4 * lane); hv[q] = (f32x4){bflo(hb.x), bfhi(hb.x), bflo(hb.y), bfhi(hb.y)}; }
#pragma unroll
        for (int k = 0; k < 4; ++k) { const int d = (int)F.misc[MW_ROWB + EIDX[t * 4 + k]] + POSE[t * 4 + k]; const float wk = WGT[t * 4 + k];
#pragma unroll
            for (int q = 0; q < 4; ++q) { const unsigned v = *(const unsigned*)(OUTP + (size_t)d * 1024 + 256 * q + 4 * lane);
                const f32x2 lo = __builtin_amdgcn_cvt_pk_f32_fp8((int)v, false), hi = __builtin_amdgcn_cvt_pk_f32_fp8((int)v, true);
                hv[q][0] += wk * lo[0]; hv[q][1] += wk * lo[1]; hv[q][2] += wk * hi[0]; hv[q][3] += wk * hi[1]; } }
        float ss = 0.f;
#pragma unroll
        for (int q = 0; q < 4; ++q) ss += hv[q][0] * hv[q][0] + hv[q][1] * hv[q][1] + hv[q][2] * hv[q][2] + hv[q][3] * hv[q][3];
        ss = wave_sum(ss); const float rstd = rsqrtf(ss * (1.f / 1024.f) + 1e-6f);
#pragma unroll
        for (int q = 0; q < 4; ++q) *(f32x4*)(F.out + (size_t)t * 1024 + 256 * q + 4 * lane) = hv[q] * rstd * nf[q];
    }
}

#define PHASE_FN __device__ __forceinline__ void
__device__ __forceinline__ Frame fresh(const Frame& F0) { Frame F = F0; int l; asm volatile("v_mbcnt_lo_u32_b32 %0, -1, 0\n\tv_mbcnt_hi_u32_b32 %0, -1, %0" : "=v"(l)); F.lane = l; F.tid = F0.wave * 64 + l; return F; }
PHASE_FN ph0(const Frame& F0) { const Frame F = fresh(F0);
    cvt_weights<false>(F, 0, CVT_SMALL); __syncthreads();
    p0_filter(F); __syncthreads();
    norm_proj32<0>(F, F.in[I_X], F.in[I_N1W], F.in[I_WIN] + 3072, IN_TOTAL, (bf16_t*)(F.ws + WS_XN));
}
PHASE_FN ph1(const Frame& F0) { const Frame F = fresh(F0);
    using namespace pg8;
    p1_rnorm(F);
    { StaticOrder S; S.init((const bf16_t*)(F.ws + WS_XN), (const bf16_t*)(F.ws + WS_WBIN), T_, 4096, 1024, F.G, F.bid);
      EpiInProj E{(bf16_t*)(F.ws + WS_PQKV), (bf16_t*)(F.ws + WS_PR), (bf16_t*)(F.ws + WS_PHY), (bf16_t*)(F.ws + WS_X0C), 0};
      gemm_phase<EpiInProj, StaticOrder>(F.lds, S, E); }
    { StaticOrder S; S.init((const bf16_t*)(F.ws + WS_XN), (const bf16_t*)(F.ws + WS_WBIN) + (size_t)4096 * 1024, T_, 2048, 1024, F.G, F.bid);
      EpiHyT E{(bf16_t*)(F.ws + WS_PHY)};
      gemm_phase<EpiHyT, StaticOrder>(F.lds, S, E); }
}
#ifndef P2_MASK
#define P2_MASK 7
#endif
PHASE_FN ph2(const Frame& F0) { const Frame F = fresh(F0); __syncthreads();
    if (P2_MASK & 4) p2_gla_prep(F); if (PROBE_PHASE == 22) { __syncthreads(); p2_gla_prep(F); } }
PHASE_FN ph3(const Frame& F0, int rep) { const Frame F = fresh(F0); p3_gla_scan(F); __syncthreads(); if (PROBE_PHASE == 30) { p3_gla_scan(F); __syncthreads(); }
    p4_conv_mfma(F, rep); if (PROBE_PHASE == 31) p4_conv_mfma(F, 1);
    { const Frame F2 = fresh(F0); cvt_weights<true>(F2, CVT_SMALL, CVT_ALL); } }
PHASE_FN ph4(const Frame& F0) { const Frame F = fresh(F0);
    using namespace pg8;
    p5_finish(F); __syncthreads(); if (PROBE_PHASE == 40) { p5_finish(F); __syncthreads(); }
    StaticOrder S; S.init(F.ws + WS_XN8, F.ws + WS_WBIN8, T_, 2048, 1024, F.G, F.bid, 1);
    EpiGates8 E{F.ws + WS_PG};
    gemm_phase<EpiGates8, StaticOrder, true>(F.lds, S, E);
}
PHASE_FN ph5(const Frame& F0) { const Frame F = fresh(F0);
    using namespace pg8;
    DualOrder S; S.init((const bf16_t*)(F.ws + WS_OGLA), (const bf16_t*)(F.ws + WS_WBBG), (unsigned)(WS_OHY - WS_OGLA), (unsigned)(WS_WBBH - WS_WBBG), T_, 1024, 1024, F.G, F.bid);
    EpiMerge E{F.ws + WS_PG, (bf16_t*)(F.ws + WS_MERGED)};
    gemm_phase<EpiMerge, DualOrder>(F.lds, S, E);
}
PHASE_FN ph6(const Frame& F0) { const Frame F = fresh(F0);
    using namespace pg8;
    StaticOrder S; S.init((const bf16_t*)(F.ws + WS_MERGED), (const bf16_t*)(F.ws + WS_WBOUT), T_, 1024, 1024, F.G, F.bid);
    EpiResid E{F.in[I_X], (bf16_t*)(F.ws + WS_H)};
    gemm_phase<EpiResid, StaticOrder>(F.lds, S, E);
}
PHASE_FN ph7(const Frame& F0) { const Frame F = fresh(F0); norm_proj32<1>(F, (const float*)(F.ws + WS_H), F.in[I_N2W], F.in[I_RW], 32, (bf16_t*)(F.ws + WS_HN)); }
PHASE_FN ph9(const Frame& F0) { const Frame F = fresh(F0);
    using namespace pg8;
    moe_offsets(F); moe_gather_tables(F, 8);
    GatherOrder S; S.init(F.ws + WS_HN, F.ws + WS_WBGU, (const LAS unsigned char*)(F.misc + MW_TILE), (const LAS unsigned char*)(F.lds + GT_SLOT), (const LAS int*)(F.lds + GT_TAB),
                          (int)F.misc[MW_RT], 2048, 1024, 1, F.G, F.bid);
    EpiGateUp E{F.in[I_BGU], F.ws + WS_ACT};
    gemm_phase<EpiGateUp, GatherOrder, true>(F.lds, S, E);
}
PHASE_FN ph10(const Frame& F0) { const Frame F = fresh(F0);
    using namespace pg8;
    moe_offsets(F);
    GroupedOrder S; S.init(F.ws + WS_ACT, F.ws + WS_WBDN, (const LAS unsigned char*)(F.misc + MW_TILE), (int)F.misc[MW_RT], 1024, 1024, 1, F.G, F.bid);
    EpiDown E{F.in[I_BDN], F.ws + WS_OUTP};
    gemm_phase<EpiDown, GroupedOrder, true>(F.lds, S, E);
}
PHASE_FN ph11(const Frame& F0) { const Frame F = fresh(F0); moe_offsets(F); p12_combine(F); }

constexpr int N_PHASES = 12;
__global__ void __launch_bounds__(NTHR, 2) hybrid_fwd(Params P) {
    extern __shared__ __attribute__((aligned(16))) unsigned char lds_raw[];
    Frame F;
    F.lds = (LAS unsigned char*)lds_raw; F.misc = (LAS unsigned*)(F.lds + MISC_OFF);
    F.tid = threadIdx.x; F.lane = F.tid & 63; F.wave = __builtin_amdgcn_readfirstlane(F.tid >> 6); F.bid = blockIdx.x; F.G = gridDim.x;
    F.in = P.in; F.out = P.out; F.ws = P.ws; F.ctl = (unsigned*)(P.ws + WS_CTL);
    if (F.tid < 4) F.misc[F.tid] = 0u;
    __syncthreads();
    XcdBarrier bar; bar.bar = F.ctl + CW_BAR; bar.x = 0; bar.st = nullptr;
    const int lo = P.ph_lo, hi = P.ph_hi;
    if (hi - lo > 1) bar = xcd_barrier_post(F.ctl + CW_BAR, (volatile LAS unsigned*)F.misc);
#ifndef ONLY_PHASE
#define ONLY_PHASE -1
#endif
#define IN(k) (lo <= (k) && (k) < hi && (ONLY_PHASE < 0 || ONLY_PHASE == (k)))
#define SEAM(k) do { if (IN(k) && IN((k) + 1)) xcd_barrier(bar); else __syncthreads(); } while (0)

    if (IN(0)) { ph0(F); if (PROBE_PHASE == 0) ph0(F); }
    SEAM(0);
    if (IN(1)) { ph1(F); if (PROBE_PHASE == 1) ph1(F); }
    SEAM(1);
    if (IN(2)) { ph2(F); if (PROBE_PHASE == 2) ph2(F); }
    SEAM(2);
    if (IN(3)) { ph3(F, 0); if (PROBE_PHASE == 3) ph3(F, 1); }
    SEAM(3);
    if (IN(4)) { ph4(F); if (PROBE_PHASE == 4) ph4(F); }
    SEAM(4);
    if (IN(5)) { ph5(F); if (PROBE_PHASE == 5) ph5(F); }
    SEAM(5);
    if (IN(6)) { ph6(F); if (PROBE_PHASE == 6) ph6(F); }
    SEAM(6);
    if (IN(7)) ph7(F);
    if (IN(7) && IN(9)) xcd_barrier(bar); else __syncthreads();
    if (IN(9)) { ph9(F); if (PROBE_PHASE == 9) ph9(F); }
    SEAM(9);
    if (IN(10)) { ph10(F); if (PROBE_PHASE == 10) ph10(F); }
    SEAM(10);
    if (IN(11)) { ph11(F); if (PROBE_PHASE == 11) ph11(F); }
#undef IN
#undef SEAM
}

extern "C" void kernel_launch(void* const* d_in, const int* in_sizes, int n_in, void* d_out, int out_size, void* d_ws, size_t ws_size, hipStream_t stream) {
    static int grid = 0;
    if (grid == 0) {
        if (n_in != 27 || out_size != T_ * D_ || ws_size < WS_END) { fprintf(stderr, "kernel_launch: unexpected shapes (n_in %d out %d ws %zu need %zu)\n", n_in, out_size, ws_size, (size_t)WS_END); grid = -1; return; }
        int dev = 0, cus = 0, per_cu = 0;
        if (hipGetDevice(&dev) != hipSuccess || hipDeviceGetAttribute(&cus, hipDeviceAttributeMultiprocessorCount, dev) != hipSuccess) { grid = -1; return; }
        if (hipFuncSetAttribute((const void*)hybrid_fwd, hipFuncAttributeMaxDynamicSharedMemorySize, LDS_BYTES) != hipSuccess) { fprintf(stderr, "kernel_launch: hipFuncSetAttribute failed\n"); grid = -1; return; }
        if (hipOccupancyMaxActiveBlocksPerMultiprocessor(&per_cu, (const void*)hybrid_fwd, NTHR, LDS_BYTES) != hipSuccess || per_cu < 1) { fprintf(stderr, "kernel_launch: occupancy query says %d\n", per_cu); (void)hipGetLastError(); }
        grid = cus;
        if (grid != 256) { fprintf(stderr, "kernel_launch: built for a 256-CU device, found %d CUs\n", cus); grid = -1; return; }
    }
    if (grid < 0) return;
    hipMemsetAsync((char*)d_ws + WS_CTL, 0, CTL_BYTES, stream);
    Params p{};
    for (int i = 0; i < 27; ++i) p.in[i] = (const float*)d_in[i];
    p.out = (float*)d_out; p.ws = (unsigned char*)d_ws;
#if MK_N_LAUNCHES == 1
    p.ph_lo = 0; p.ph_hi = N_PHASES;
    hipLaunchKernelGGL(hybrid_fwd, dim3(grid), dim3(NTHR), LDS_BYTES, stream, p);
#else
    for (int k = 0; k < 12; ++k) { p.ph_lo = k; p.ph_hi = k + 1; hipLaunchKernelGGL(hybrid_fwd, dim3(grid), dim3(NTHR), LDS_BYTES, stream, p); }
#endif
}
```

```cpp
#include <hip/hip_runtime.h>
#include <cstdio>
#include <cstdint>

#ifndef MK_N_LAUNCHES
#define MK_N_LAUNCHES 1
#endif

#ifndef PROBE_PHASE
#define PROBE_PHASE -1
#endif
#define LAS __attribute__((address_space(3)))
typedef unsigned short bf16_t;
typedef short bf16x8 __attribute__((ext_vector_type(8)));
typedef float f32x4 __attribute__((ext_vector_type(4)));
typedef float f32x16 __attribute__((ext_vector_type(16)));
typedef unsigned u32x4 __attribute__((ext_vector_type(4)));
typedef unsigned u32x2 __attribute__((ext_vector_type(2)));
typedef int i32x8 __attribute__((ext_vector_type(8)));
typedef float f32x2 __attribute__((ext_vector_type(2)));
typedef int i32x4 __attribute__((ext_vector_type(4)));
constexpr float W8_SCALE = 32.f, W8_INV = 1.f / 32.f;
__device__ __forceinline__ unsigned pk4_fp8(float a, float b, float c, float d) { int v = __builtin_amdgcn_cvt_pk_fp8_f32(a, b, 0, false); v = __builtin_amdgcn_cvt_pk_fp8_f32(c, d, v, true); return (unsigned)v; }

constexpr int T_ = 32768, D_ = 1024, L_ = 4096, NB_ = 8;
constexpr int NTHR = 512;
constexpr int NEXP = 32, TOPK = 4;
constexpr int MAXROWS = T_ * TOPK + NEXP * 256;
constexpr int IN_TOTAL = 8224;

constexpr int REG_BYTES = 150528, MISC_OFF = REG_BYTES, MISC_BYTES = 8192, LDS_BYTES = REG_BYTES + MISC_BYTES;
constexpr int MW_Q = 8, MW_CNT = 16, MW_BASE = 48, MW_ROWB = 80, MW_RT = 113, MW_SEL = 256, MW_TILE = 1792;

constexpr size_t MiB = 1048576;
constexpr size_t WS_CTL = 0, CTL_BYTES = 65536;
constexpr size_t WS_EIDX = 1 * MiB, WS_POSE = WS_EIDX + MiB / 2, WS_WGT = 2 * MiB, WS_DEST = WS_WGT + MiB / 2, WS_SUMSQ = 3 * MiB;
constexpr size_t WS_R1 = 5 * MiB;
constexpr size_t WS_QT = WS_R1, WS_KT = WS_R1 + 64 * MiB, WS_KE = WS_R1 + 128 * MiB;
constexpr size_t WS_A = 197 * MiB, WS_B = WS_A + 272 * MiB, WS_C = WS_B + 272 * MiB, WS_END = WS_C + 256 * MiB;
constexpr size_t WS_PHY = WS_A, WS_PR = WS_A + 192 * MiB, WS_WBIN = WS_A + 256 * MiB;
constexpr size_t WS_OF = WS_C, WS_OB = WS_C + 192 * MiB, WS_Y = WS_A + 128 * MiB;
constexpr size_t WS_HNS = WS_A, WS_OUTP = WS_A;
constexpr size_t WS_PQKV = WS_B, WS_PG = WS_B, WS_ALOW = WS_B + 256 * MiB,
     WS_WBBG = WS_B + 260 * MiB, WS_WBBH = WS_B + 262 * MiB, WS_WBOUT = WS_B + 264 * MiB;
constexpr size_t WS_HRAW = WS_C + 128 * MiB  , WS_DEC = WS_B + 266 * MiB, WS_XN8 = WS_B + 224 * MiB, WS_WBIN8 = WS_WBIN + 12 * MiB, WS_LIST = WS_B + 64 * MiB;
constexpr size_t WS_WBGU = WS_B + 128 * MiB, WS_WBDN = WS_B + 192 * MiB;
constexpr size_t WS_OGLA = WS_R1, WS_OHY = WS_R1 + 64 * MiB, WS_ACT = WS_R1;
constexpr size_t WS_Z = WS_C, WS_M1 = WS_C, WS_HN = WS_C, WS_X0C = WS_C + 64 * MiB, WS_MERGED = WS_X0C, WS_RT = WS_C + 128 * MiB, WS_XN = WS_C + 192 * MiB, WS_H = WS_RT;
constexpr size_t WS_ZT = WS_Z, WS_YT = WS_Y, WS_RN = WS_CTL + 65536;
constexpr int CW_BAR = 0;
constexpr int CW_GCOUNT = 4096;
constexpr int CW_CONVQ = 4160;
constexpr int CW_CVTQ = 4352;

__device__ __forceinline__ float bf2f(bf16_t b) { return __uint_as_float(((unsigned)b) << 16); }
__device__ __forceinline__ float bflo(unsigned w) { return __uint_as_float(w << 16); }
__device__ __forceinline__ float bfhi(unsigned w) { return __uint_as_float(w & 0xffff0000u); }
typedef __bf16 bf16v2_t __attribute__((ext_vector_type(2)));
__device__ __forceinline__ bf16_t f2bf(float f) { return __builtin_bit_cast(unsigned short, (__bf16)f); }
__device__ __forceinline__ unsigned pk2(float lo, float hi) { bf16v2_t v; v.x = (__bf16)lo; v.y = (__bf16)hi; return __builtin_bit_cast(unsigned, v); }
__device__ __forceinline__ unsigned pkc(float lo, float hi) { bf16v2_t v; v.x = (__bf16)lo; v.y = (__bf16)hi; return __builtin_bit_cast(unsigned, v); }
__device__ __forceinline__ bf16x8 pack8(const f32x16& x, int s8) { u32x4 p; p.x = pkc(x[s8], x[s8 + 1]); p.y = pkc(x[s8 + 2], x[s8 + 3]); p.z = pkc(x[s8 + 4], x[s8 + 5]); p.w = pkc(x[s8 + 6], x[s8 + 7]); return __builtin_bit_cast(bf16x8, p); }
__device__ __forceinline__ int swap23(int k) { return 8 * ((k >> 2) & 1) + 4 * (k >> 3) + (k & 3); }
__device__ __forceinline__ float sigmoidf_(float x) { return __builtin_amdgcn_rcpf(1.f + __expf(-x)); }
__device__ __forceinline__ float wave_sum(float v) {
#pragma unroll
    for (int o = 32; o > 0; o >>= 1) v += __shfl_xor(v, o);
    return v;
}

namespace pg8 {
#define PG8_LAS __attribute__((address_space(3)))
constexpr int BM = 256, BK = 64, HALF = 128, HTB = HALF * BK * 2, STAGE_BYTES = 8 * HTB, NXCD = 8, WGM = 8;
__host__ __device__ __forceinline__ int lds_byte(int r, int c) { const int st = (r >> 4) * 2 + (c >> 5), rr = r & 15, cc = c & 31, ob = rr * 64 + cc * 2; return st * 1024 + (ob ^ (((ob >> 9) & 1) << 5)); }
__host__ __device__ __forceinline__ void stage_rc(int b, int& R, int& C) { const int st = b / 1024, sb = b % 1024, swz = sb ^ (((sb >> 9) & 1) << 5); R = (st >> 1) * 16 + swz / 64; C = (st & 1) * 32 + (swz % 64) / 2; }
__host__ __device__ __forceinline__ int perm32(int rho) { const int n = rho >> 4, i = rho & 15; return 8 * (i >> 2) + 4 * n + (i & 3); }

struct Unit { int pm, pn, e; };

__device__ __forceinline__ void tile_of(int wgid, int nM, int nN, int& pm, int& pn) {
    const int nwg = nM * nN;
    { const int q = nwg / NXCD, r = nwg % NXCD, xcd = wgid % NXCD, off = wgid / NXCD; wgid = (xcd < r ? xcd * (q + 1) : r * (q + 1) + (xcd - r) * q) + off; }
    const int nig = WGM * nN, gid = wgid / nig, fm = gid * WGM, gsz = (nM - fm) < WGM ? (nM - fm) : WGM;
    pm = fm + ((wgid % nig) % gsz); pn = (wgid % nig) / gsz;
}
struct StaticOrder {
    static constexpr bool GATHER = false;
    const bf16_t* A; const bf16_t* Bt; int K, pitch, nM, nN, nwg, G, c;
    __device__ void init(const void* A_, const void* Bt_, int M, int N, int K_, int G_, int c_, int esz = 2) { A = (const bf16_t*)A_; Bt = (const bf16_t*)Bt_; K = K_; pitch = esz * K_; nM = M / BM; nN = N / BM; nwg = nM * nN; G = G_; c = c_; }
    __device__ __forceinline__ bool next(int i, Unit& u) const {
        const long Lq = (long)i * G + c; if (Lq >= nwg) return false;
        tile_of((int)Lq, nM, nN, u.pm, u.pn); u.e = 0; return true;
    }
    __device__ __forceinline__ const void* a_base() const { return A; }
    __device__ __forceinline__ const void* b_base() const { return Bt; }
    __device__ __forceinline__ unsigned a_off(const Unit& u) const { return (unsigned)(u.pm * BM) * (unsigned)pitch; }
    __device__ __forceinline__ unsigned b_off(const Unit& u) const { return (unsigned)(u.pn * BM) * (unsigned)pitch; }
};
struct DualOrder {
    static constexpr bool GATHER = false;
    const bf16_t* A; const bf16_t* Bt; unsigned a2, b2; int K, pitch, nM, nN, nwg, G, c;
    __device__ void init(const bf16_t* A_, const bf16_t* Bt_, unsigned a2_, unsigned b2_, int M, int N, int K_, int G_, int c_) { A = A_; Bt = Bt_; a2 = a2_; b2 = b2_; K = K_; pitch = 2 * K_; nM = M / BM; nN = N / BM; nwg = nM * nN; G = G_; c = c_; }
    __device__ __forceinline__ bool next(int i, Unit& u) const {
        const long Lq = (long)(i >> 1) * G + c; if (Lq >= nwg) return false;
        tile_of((int)Lq, nM, nN, u.pm, u.pn); u.e = i & 1; return true;
    }
    __device__ __forceinline__ const void* a_base() const { return A; }
    __device__ __forceinline__ const void* b_base() const { return Bt; }
    __device__ __forceinline__ unsigned a_off(const Unit& u) const { return (unsigned)(u.pm * BM) * (unsigned)pitch + (u.e ? a2 : 0u); }
    __device__ __forceinline__ unsigned b_off(const Unit& u) const { return (unsigned)(u.pn * BM) * (unsigned)pitch + (u.e ? b2 : 0u); }
};
struct GroupedOrder {
    static constexpr bool GATHER = false;
    const void* A; const void* Bt; const LAS unsigned char* tile_e; int K, pitch, N, nM, nN, nwg, G, c;
    __device__ void init(const void* A_, const void* Bt_, const LAS unsigned char* te, int RT, int N_, int K_, int esz, int G_, int c_) { A = A_; Bt = Bt_; tile_e = te; K = K_; pitch = esz * K_; N = N_; nM = RT; nN = N_ / BM; nwg = nM * nN; G = G_; c = c_; }
    __device__ __forceinline__ bool next(int i, Unit& u) const {
        const long Lq = (long)i * G + c; if (Lq >= nwg) return false;
        tile_of((int)Lq, nM, nN, u.pm, u.pn); u.e = tile_e[u.pm]; return true;
    }
    __device__ __forceinline__ const void* a_base() const { return A; }
    __device__ __forceinline__ const void* b_base() const { return Bt; }
    __device__ __forceinline__ unsigned a_off(const Unit& u) const { return (unsigned)(u.pm * BM) * (unsigned)pitch; }
    __device__ __forceinline__ unsigned b_off(const Unit& u) const { return (unsigned)(u.e * N + u.pn * BM) * (unsigned)pitch; }
};

struct GatherOrder {
    static constexpr bool GATHER = true;
    const void* A; const void* Bt; const LAS unsigned char* tile_e; const LAS unsigned char* slot; const LAS int* tab; int K, pitch, N, nM, nN, nwg, G, c;
    __device__ void init(const void* A_, const void* Bt_, const LAS unsigned char* te, const LAS unsigned char* sl, const LAS int* tb, int RT, int N_, int K_, int esz, int G_, int c_) { A = A_; Bt = Bt_; tile_e = te; slot = sl; tab = tb; K = K_; pitch = esz * K_; N = N_; nM = RT; nN = N_ / BM; nwg = nM * nN; G = G_; c = c_; }
    __device__ __forceinline__ bool next(int i, Unit& u) const {
        const long Lq = (long)i * G + c; if (Lq >= nwg) return false;
        tile_of((int)Lq, nM, nN, u.pm, u.pn); u.e = tile_e[u.pm]; return true;
    }
    __device__ __forceinline__ const void* a_base() const { return A; }
    __device__ __forceinline__ const void* b_base() const { return Bt; }
    __device__ __forceinline__ unsigned a_off(const Unit&) const { return 0u; }
    __device__ __forceinline__ unsigned b_off(const Unit& u) const { return (unsigned)(u.e * N + u.pn * BM) * (unsigned)pitch; }
    __device__ __forceinline__ int row_of(const Unit& u, int r) const { return tab[(int)slot[u.pm] * 256 + r]; }
};

__device__ __forceinline__ unsigned cvt_pk_bf16(float lo, float hi) { unsigned r; asm volatile("v_cvt_pk_bf16_f32 %0, %1, %2" : "=v"(r) : "v"(lo), "v"(hi)); return r; }

template <class E, class = void> struct EpiTrans { static constexpr bool value = false; };
template <class E> struct EpiTrans<E, decltype((void)E::TRANS)> { static constexpr bool value = E::TRANS; };
template <class Epi, class Sched, bool F8 = false>
__device__ __forceinline__ void gemm_phase(PG8_LAS unsigned char* lds, const Sched& S, const Epi& E) {
    constexpr bool TR = EpiTrans<Epi>::value;
    static_assert(!(TR && (F8 || Sched::GATHER)), "transposed output: bf16 dense only");
    int lane; asm volatile("v_mbcnt_lo_u32_b32 %0, -1, 0\n\tv_mbcnt_hi_u32_b32 %0, -1, %0" : "=v"(lane));
    const int wid = __builtin_amdgcn_readfirstlane(threadIdx.x >> 6), tid = wid * 64 + lane, wr = wid >> 2, wc = wid & 3, fr = lane & 15, fq = lane >> 4;
    const int pitch = S.pitch, nt = pitch / 128;
    unsigned voffA[2][2], voffN[2][2], voffB[2]; int rowA[2], colA[2];
#pragma unroll
    for (int i = 0; i < 2; ++i) { int R, C; stage_rc(tid * 16 + i * 8192, R, C); const int Rp = Epi::PERM ? ((R & ~31) + perm32(R & 31)) : R, Rb = TR ? R : Rp, Ra = TR ? Rp : R;
        rowA[i] = R; colA[i] = C; voffB[i] = (unsigned)(Rb * pitch + C * 2);
#pragma unroll
        for (int hf = 0; hf < 2; ++hf) { voffA[hf][i] = (unsigned)((Ra + HALF * hf) * pitch + C * 2); voffN[hf][i] = voffA[hf][i]; } }
    const unsigned kstep = 128u, hstep = (unsigned)(HALF * pitch);
    const unsigned ldsw = (unsigned)wid * 1024u;
    const int aoff = lds_byte(wr * 64 + fr, fq * 8), boff = lds_byte(wc * 32 + fr, fq * 8);
    const __amdgpu_buffer_rsrc_t rA = __builtin_amdgcn_make_buffer_rsrc((void*)S.a_base(), 0, 0x7FFFFFFF, 0x00020000), rB = __builtin_amdgcn_make_buffer_rsrc((void*)S.b_base(), 0, 0x7FFFFFFF, 0x00020000);
#define PG8_SA(b, h) (((b) * 2 + (h)) * HTB)
#define PG8_SB(b, h) ((4 + (b) * 2 + (h)) * HTB)
#define PG8_SBR(b, h) (((b) * 2 + (h)) * HTB)
    const PG8_LAS unsigned char* ldsB = lds + 4 * HTB + boff; asm volatile("" : "+v"(ldsB));
#define PG8_STAGE(bufoff, rsrc, soff, voff) do { _Pragma("unroll") for (int _i = 0; _i < 2; ++_i) \
        __builtin_amdgcn_raw_ptr_buffer_load_lds(rsrc, (PG8_LAS void*)(lds + (bufoff) + ldsw + _i * 8192), 16, (voff)[_i], (int)(soff), 0, 0); } while (0)
#define PG8_GATHER_OFFS(dst, unit) do { if constexpr (Sched::GATHER) { _Pragma("unroll") for (int _h = 0; _h < 2; ++_h) _Pragma("unroll") for (int _i = 0; _i < 2; ++_i) \
        dst[_h][_i] = (unsigned)(S.row_of(unit, rowA[_i] + HALF * _h) * pitch + colA[_i] * 2); } } while (0)
#define PG8_LDA(dst, b, h) do { _Pragma("unroll") for (int m = 0; m < 4; ++m) { if constexpr (F8) { const i32x4 _lo = *(const PG8_LAS i32x4*)(lds + PG8_SA(b, h) + aoff + m * 2048), _hi = *(const PG8_LAS i32x4*)(lds + PG8_SA(b, h) + aoff + m * 2048 + 1024); dst##8[m] = __builtin_shufflevector(_lo, _hi, 0, 1, 2, 3, 4, 5, 6, 7); } \
        else { _Pragma("unroll") for (int k = 0; k < 2; ++k) dst[m][k] = *(const PG8_LAS bf16x8*)(lds + PG8_SA(b, h) + aoff + m * 2048 + k * 1024); } } } while (0)
#define PG8_LDB(dst, b, h) do { _Pragma("unroll") for (int n = 0; n < 2; ++n) { if constexpr (F8) { const i32x4 _lo = *(const PG8_LAS i32x4*)(ldsB + PG8_SBR(b, h) + n * 2048), _hi = *(const PG8_LAS i32x4*)(ldsB + PG8_SBR(b, h) + n * 2048 + 1024); dst##8[n] = __builtin_shufflevector(_lo, _hi, 0, 1, 2, 3, 4, 5, 6, 7); } \
        else { _Pragma("unroll") for (int k = 0; k < 2; ++k) dst[n][k] = *(const PG8_LAS bf16x8*)(ldsB + PG8_SBR(b, h) + n * 2048 + k * 1024); } } } while (0)
#define PG8_MMA(ai, bj, At, Bt) do { __builtin_amdgcn_s_setprio(1); _Pragma("unroll") for (int m = 0; m < 4; ++m) _Pragma("unroll") for (int n = 0; n < 2; ++n) { if constexpr (F8) { \
            asm volatile("v_mfma_scale_f32_16x16x128_f8f6f4 %0, %1, %2, %0, %3, %3 op_sel_hi:[0,0,0]" : "+v"(acc[ai][bj][m][n]) : "v"(Bt##8[n]), "v"(At##8[m]), "v"(sc8)); } \
        else { _Pragma("unroll") for (int k = 0; k < 2; ++k) { if constexpr (TR) acc[ai][bj][m][n] = __builtin_amdgcn_mfma_f32_16x16x32_bf16(At[m][k], Bt[n][k], acc[ai][bj][m][n], 0, 0, 0); \
            else acc[ai][bj][m][n] = __builtin_amdgcn_mfma_f32_16x16x32_bf16(Bt[n][k], At[m][k], acc[ai][bj][m][n], 0, 0, 0); } } } \
        __builtin_amdgcn_s_setprio(0); } while (0)
#define PG8_WAIT_V(n) asm volatile("s_waitcnt vmcnt(" #n ")" ::: "memory")
#define PG8_WAIT_V8R() do { if (relax_now) asm volatile("s_waitcnt vmcnt(%0)" :: "n"(8 + Epi::NSTORES) : "memory"); else asm volatile("s_waitcnt vmcnt(8)" ::: "memory"); } while (0)
#define PG8_WAIT_L(n) asm volatile("s_waitcnt lgkmcnt(" #n ")" ::: "memory")
#define PG8_BAR __builtin_amdgcn_s_barrier()
#define PG8_SCHED __builtin_amdgcn_sched_barrier(0)
    Unit cur, nxt; int ui = 0; bool relax = false;
    if (!S.next(0, cur)) return;
    f32x4 acc[2][2][4][2];
#pragma unroll
    for (int a = 0; a < 2; ++a)
#pragma unroll
        for (int b = 0; b < 2; ++b)
#pragma unroll
            for (int m = 0; m < 4; ++m)
#pragma unroll
                for (int n = 0; n < 2; ++n) acc[a][b][m][n] = (f32x4){0.f, 0.f, 0.f, 0.f};
    bf16x8 At[4][2], B0[2][2], B1[2][2]; i32x8 At8[4], B08[2], B18[2];
    const int sc8 = 0x7F7F7F7F;
    unsigned cA = S.a_off(cur), cB = S.b_off(cur);
    PG8_GATHER_OFFS(voffA, cur);
    PG8_STAGE(PG8_SB(0, 0), rB, cB, voffB); PG8_STAGE(PG8_SB(0, 1), rB, cB + hstep, voffB); PG8_STAGE(PG8_SA(0, 0), rA, cA, voffA[0]); PG8_STAGE(PG8_SA(0, 1), rA, cA, voffA[1]);
    if (wr == 1) PG8_BAR;
    PG8_WAIT_V(2); PG8_BAR;
    PG8_STAGE(PG8_SB(1, 0), rB, cB + kstep, voffB); PG8_STAGE(PG8_SA(1, 0), rA, cA + kstep, voffA[0]); PG8_STAGE(PG8_SB(1, 1), rB, cB + hstep + kstep, voffB);
    PG8_WAIT_V(6); PG8_BAR;
    for (;;) {
        const bool has_next = S.next(ui + 1, nxt);
        const unsigned nA = has_next ? S.a_off(nxt) : cA, nB = has_next ? S.b_off(nxt) : cB;
        if constexpr (Sched::GATHER) { if (has_next) { PG8_GATHER_OFFS(voffN, nxt); } else {
#pragma unroll
            for (int hf = 0; hf < 2; ++hf) { voffN[hf][0] = voffA[hf][0]; voffN[hf][1] = voffA[hf][1]; } } }
        for (int t = 0; t < nt; t += 2) {
            const bool last = (t == nt - 2), relax_now = relax && (t == 0);
            unsigned v2[2][2];
#pragma unroll
            for (int hf = 0; hf < 2; ++hf) { if constexpr (Sched::GATHER) { v2[hf][0] = last ? voffN[hf][0] : voffA[hf][0]; v2[hf][1] = last ? voffN[hf][1] : voffA[hf][1]; } else { v2[hf][0] = voffA[hf][0]; v2[hf][1] = voffA[hf][1]; } }
            const unsigned a1 = cA + (unsigned)(t + 1) * kstep;
            const unsigned a2 = last ? nA : cA + (unsigned)(t + 2) * kstep, b2 = last ? nB : cB + (unsigned)(t + 2) * kstep;
            const unsigned a3 = a2 + kstep, b3 = b2 + kstep;
            PG8_LDB(B0, 0, 0); PG8_LDB(B1, 0, 1); PG8_SCHED; PG8_LDA(At, 0, 0); PG8_STAGE(PG8_SA(1, 1), rA, a1, voffA[1]);
            PG8_WAIT_V8R(); PG8_WAIT_L(0); PG8_BAR; PG8_MMA(0, 0, At, B0); PG8_MMA(0, 1, At, B1); PG8_BAR; PG8_SCHED;
            PG8_LDA(At, 0, 1); PG8_STAGE(PG8_SB(0, 0), rB, b2, voffB); PG8_STAGE(PG8_SB(0, 1), rB, b2 + hstep, voffB); PG8_STAGE(PG8_SA(0, 0), rA, a2, v2[0]);
            PG8_WAIT_V8R(); PG8_WAIT_L(0); PG8_BAR; PG8_MMA(1, 0, At, B0); PG8_MMA(1, 1, At, B1); PG8_BAR; PG8_SCHED;
            PG8_LDB(B0, 1, 0); PG8_LDB(B1, 1, 1); PG8_SCHED; PG8_LDA(At, 1, 0); PG8_STAGE(PG8_SA(0, 1), rA, a2, v2[1]);
            PG8_WAIT_V(8); PG8_WAIT_L(0); PG8_BAR; PG8_MMA(0, 0, At, B0); PG8_MMA(0, 1, At, B1); PG8_BAR; PG8_SCHED;
            PG8_LDA(At, 1, 1); PG8_STAGE(PG8_SB(1, 0), rB, b3, voffB); PG8_STAGE(PG8_SB(1, 1), rB, b3 + hstep, voffB); PG8_STAGE(PG8_SA(1, 0), rA, a3, v2[0]);
            PG8_WAIT_V(8); PG8_WAIT_L(0); PG8_BAR; PG8_MMA(1, 0, At, B0); PG8_MMA(1, 1, At, B1); PG8_BAR; PG8_SCHED;
        }
        if (wr == 0) PG8_BAR;
        if constexpr (F8) asm volatile("s_nop 15\n\ts_nop 3" ::: "memory");
        { int l2; asm volatile("v_mbcnt_lo_u32_b32 %0, -1, 0\n\tv_mbcnt_hi_u32_b32 %0, -1, %0" : "=v"(l2)); E(acc, cur, wr, wc, l2 & 15, l2 >> 4); if (PROBE_PHASE == 100) E(acc, cur, wr, wc, l2 & 15, l2 >> 4); }
        if (!has_next) break;
        if (!(Epi::DUAL && cur.e == 0)) {
#pragma unroll
        for (int a = 0; a < 2; ++a)
#pragma unroll
            for (int b = 0; b < 2; ++b)
#pragma unroll
                for (int m = 0; m < 4; ++m)
#pragma unroll
                    for (int n = 0; n < 2; ++n) acc[a][b][m][n] = (f32x4){0.f, 0.f, 0.f, 0.f};
        }
        relax = Epi::DUAL ? (cur.e == 1) : true;
        cur = nxt; cA = nA; cB = nB; ++ui;
        if constexpr (Sched::GATHER) {
#pragma unroll
            for (int hf = 0; hf < 2; ++hf) { voffA[hf][0] = voffN[hf][0]; voffA[hf][1] = voffN[hf][1]; } }
        if (wr == 1) PG8_BAR;
    }
    PG8_WAIT_V(0);
    PG8_BAR;
#undef PG8_SA
#undef PG8_SB
#undef PG8_SBR
#undef PG8_STAGE
#undef PG8_GATHER_OFFS
#undef PG8_LDA
#undef PG8_LDB
#undef PG8_MMA
#undef PG8_WAIT_V
#undef PG8_WAIT_V8R
#undef PG8_WAIT_L
#undef PG8_BAR
#undef PG8_SCHED
}

__device__ __forceinline__ void store16_pair(unsigned char* px, unsigned char* py, u32x2 a, u32x2 b, int fq) {
    const auto r0 = __builtin_amdgcn_permlane16_swap(a.x, b.x, false, false);
    const auto r1 = __builtin_amdgcn_permlane16_swap(a.y, b.y, false, false);
    u32x4 w; w.x = r0[0]; w.y = r1[0]; w.z = r0[1]; w.w = r1[1];
    *(u32x4*)((fq & 1) ? (py - 8) : px) = w;
}
struct EpiInProj {
    static constexpr int NSTORES = 16;
    static constexpr bool DUAL = false;
    static constexpr bool PERM = true;
    bf16_t *qkv, *r, *hy, *g; int pn_off;
    __device__ __forceinline__ void operator()(const f32x4 (&acc)[2][2][4][2], const Unit& u0, int wr, int wc, int fr, int fq) const {
        Unit u = u0; u.pn += pn_off;
        bf16_t* base; int ldc, ct;
        if (u.pn < 8) { base = qkv; ldc = 2048; ct = u.pn; } else if (u.pn < 12) { base = r; ldc = 1024; ct = u.pn - 8; }
        else if (u.pn < 16) { base = g; ldc = 1024; ct = u.pn - 12; } else { base = hy; ldc = 2048; ct = u.pn - 16; }
        const float sc = (u.pn < 2) ? 0.08838834764831845f : 1.f;
        const int row0 = u.pm * BM + wr * 64 + fr, col0 = ct * BM + wc * 32 + 8 * fq;
#pragma unroll
        for (int ai = 0; ai < 2; ++ai)
#pragma unroll
            for (int m = 0; m < 4; ++m) { bf16_t* rowp = base + (size_t)(row0 + ai * HALF + m * 16) * ldc + col0;
#pragma unroll
                for (int bj = 0; bj < 2; ++bj) { const f32x4 v0 = acc[ai][bj][m][0] * sc, v1 = acc[ai][bj][m][1] * sc; u32x4 w;
                    w.x = cvt_pk_bf16(v0[0], v0[1]); w.y = cvt_pk_bf16(v0[2], v0[3]); w.z = cvt_pk_bf16(v1[0], v1[1]); w.w = cvt_pk_bf16(v1[2], v1[3]);
                    *(u32x4*)(rowp + bj * HALF) = w; } }
    }
};
struct EpiHyT {
    static constexpr int NSTORES = 16;
    static constexpr bool DUAL = false, PERM = true, TRANS = true;
    bf16_t* XT;
    __device__ __forceinline__ void operator()(const f32x4 (&acc)[2][2][4][2], const Unit& u, int wr, int wc, int fr, int fq) const {
        const int row0 = u.pm * BM + wr * 64 + 8 * fq, col0 = u.pn * BM + wc * 32 + fr;
#pragma unroll
        for (int bj = 0; bj < 2; ++bj)
#pragma unroll
            for (int n = 0; n < 2; ++n) { bf16_t* colp = XT + (size_t)(col0 + bj * HALF + n * 16) * T_ + row0;
#pragma unroll
                for (int ai = 0; ai < 2; ++ai)
#pragma unroll
                    for (int mp = 0; mp < 2; ++mp) { const f32x4 v0 = acc[ai][bj][2 * mp][n], v1 = acc[ai][bj][2 * mp + 1][n]; u32x4 w;
                        w.x = cvt_pk_bf16(v0[0], v0[1]); w.y = cvt_pk_bf16(v0[2], v0[3]); w.z = cvt_pk_bf16(v1[0], v1[1]); w.w = cvt_pk_bf16(v1[2], v1[3]);
                        *(u32x4*)(colp + ai * HALF + mp * 32) = w; } }
    }
};
struct EpiGates8 {
    static constexpr int NSTORES = 8;
    static constexpr bool CONT64 = false;
    static constexpr bool PERM = true, DUAL = false;
    unsigned char* G8;
    __device__ __forceinline__ void operator()(const f32x4 (&acc)[2][2][4][2], const Unit& u, int wr, int wc, int fr, int fq) const {
        const int row0 = u.pm * BM + wr * 64 + fr, col0 = u.pn * BM + wc * 32 + 8 * fq;
#pragma unroll
        for (int ai = 0; ai < 2; ++ai)
#pragma unroll
            for (int mp = 0; mp < 2; ++mp) { unsigned char* rowx = G8 + (size_t)(row0 + ai * HALF + (2 * mp) * 16) * 2048 + col0; unsigned char* rowy = rowx + 16 * 2048;
#pragma unroll
                for (int bj = 0; bj < 2; ++bj) { u32x2 a, b;
                    { const f32x4 v0 = acc[ai][bj][2 * mp][0] * W8_INV, v1 = acc[ai][bj][2 * mp][1] * W8_INV; a.x = pk4_fp8(v0[0], v0[1], v0[2], v0[3]); a.y = pk4_fp8(v1[0], v1[1], v1[2], v1[3]); }
                    { const f32x4 v0 = acc[ai][bj][2 * mp + 1][0] * W8_INV, v1 = acc[ai][bj][2 * mp + 1][1] * W8_INV; b.x = pk4_fp8(v0[0], v0[1], v0[2], v0[3]); b.y = pk4_fp8(v1[0], v1[1], v1[2], v1[3]); }
                    store16_pair(rowx + bj * HALF, rowy + bj * HALF, a, b, fq); } }
    }
};
struct EpiMerge {
    static constexpr int NSTORES = 16;
    static constexpr bool PERM = true, DUAL = true;
    const unsigned char* g; bf16_t* O;
    __device__ __forceinline__ void operator()(f32x4 (&acc)[2][2][4][2], const Unit& u, int wr, int wc, int fr, int fq) const {
        const int row0 = u.pm * BM + wr * 64 + fr, col0 = u.pn * BM + wc * 32 + 8 * fq;
#pragma unroll
        for (int ai = 0; ai < 2; ++ai)
#pragma unroll
            for (int m = 0; m < 4; ++m) { const size_t row = (size_t)(row0 + ai * HALF + m * 16);
#pragma unroll
                for (int bj = 0; bj < 2; ++bj) { const int col = col0 + bj * HALF;
                    const u32x2 g2w = *(const u32x2*)(g + row * 2048 + 1024 + col);
                    const f32x2 a0 = __builtin_amdgcn_cvt_pk_f32_fp8((int)g2w.x, false), a1 = __builtin_amdgcn_cvt_pk_f32_fp8((int)g2w.x, true), a2 = __builtin_amdgcn_cvt_pk_f32_fp8((int)g2w.y, false), a3 = __builtin_amdgcn_cvt_pk_f32_fp8((int)g2w.y, true);
                    float e2[8] = {__expf(-a0[0]), __expf(-a0[1]), __expf(-a1[0]), __expf(-a1[1]), __expf(-a2[0]), __expf(-a2[1]), __expf(-a3[0]), __expf(-a3[1])};
                    if (u.e == 0) { const u32x2 g1w = *(const u32x2*)(g + row * 2048 + col);
                        const f32x2 c0 = __builtin_amdgcn_cvt_pk_f32_fp8((int)g1w.x, false), c1 = __builtin_amdgcn_cvt_pk_f32_fp8((int)g1w.x, true), c2 = __builtin_amdgcn_cvt_pk_f32_fp8((int)g1w.y, false), c3 = __builtin_amdgcn_cvt_pk_f32_fp8((int)g1w.y, true);
                        const float e1[8] = {__expf(-c0[0]), __expf(-c0[1]), __expf(-c1[0]), __expf(-c1[1]), __expf(-c2[0]), __expf(-c2[1]), __expf(-c3[0]), __expf(-c3[1])};
#pragma unroll
                        for (int i = 0; i < 4; ++i) { acc[ai][bj][m][0][i] *= (1.f + e2[i]) * __builtin_amdgcn_rcpf(1.f + e1[i]); acc[ai][bj][m][1][i] *= (1.f + e2[4 + i]) * __builtin_amdgcn_rcpf(1.f + e1[4 + i]); } }
                    else { f32x4 v0, v1;
#pragma unroll
                        for (int i = 0; i < 4; ++i) { v0[i] = acc[ai][bj][m][0][i] * __builtin_amdgcn_rcpf(1.f + e2[i]); v1[i] = acc[ai][bj][m][1][i] * __builtin_amdgcn_rcpf(1.f + e2[4 + i]); }
                        u32x4 w; w.x = cvt_pk_bf16(v0[0], v0[1]); w.y = cvt_pk_bf16(v0[2], v0[3]); w.z = cvt_pk_bf16(v1[0], v1[1]); w.w = cvt_pk_bf16(v1[2], v1[3]);
                        *(u32x4*)(O + row * 1024 + col) = w; } } }
    }
};
struct EpiResid {
    static constexpr int NSTORES = 16;
    static constexpr bool DUAL = false;
    static constexpr bool PERM = true;
    const float* x; bf16_t* H;
    __device__ __forceinline__ void operator()(const f32x4 (&acc)[2][2][4][2], const Unit& u, int wr, int wc, int fr, int fq) const {
        const int row0 = u.pm * BM + wr * 64 + fr, col0 = u.pn * BM + wc * 32 + 8 * fq;
#pragma unroll
        for (int ai = 0; ai < 2; ++ai)
#pragma unroll
            for (int m = 0; m < 4; ++m) { const size_t ro = (size_t)(row0 + ai * HALF + m * 16) * 1024 + col0;
#pragma unroll
                for (int bj = 0; bj < 2; ++bj) { const size_t o = ro + bj * HALF; const f32x4 v0 = acc[ai][bj][m][0] + *(const f32x4*)(x + o), v1 = acc[ai][bj][m][1] + *(const f32x4*)(x + o + 4); u32x4 w;
                    w.x = cvt_pk_bf16(v0[0], v0[1]); w.y = cvt_pk_bf16(v0[2], v0[3]); w.z = cvt_pk_bf16(v1[0], v1[1]); w.w = cvt_pk_bf16(v1[2], v1[3]);
                    *(u32x4*)(H + o) = w; } }
    }
};
struct EpiGateUp {
    static constexpr int NSTORES = 4;
    static constexpr bool CONT64 = false;
    static constexpr bool DUAL = false;
    static constexpr bool PERM = true;
    const float* bgu; unsigned char* ACT;
    __device__ __forceinline__ void operator()(const f32x4 (&acc)[2][2][4][2], const Unit& u, int wr, int wc, int fr, int fq) const {
        const int row0 = u.pm * BM + wr * 64 + fr, j0 = u.pn * HALF + wc * 32 + 8 * fq;
        const float* bg = bgu + (size_t)u.e * 2048 + j0;
        const f32x4 bg0 = *(const f32x4*)(bg), bg1 = *(const f32x4*)(bg + 4), bu0 = *(const f32x4*)(bg + 1024), bu1 = *(const f32x4*)(bg + 1028);
#pragma unroll
        for (int ai = 0; ai < 2; ++ai)
#pragma unroll
            for (int mp = 0; mp < 2; ++mp) { u32x2 pc[2];
#pragma unroll
                for (int h2 = 0; h2 < 2; ++h2) { const int m = 2 * mp + h2;
                    const f32x4 g0 = acc[ai][0][m][0] * W8_INV + bg0, g1 = acc[ai][0][m][1] * W8_INV + bg1, u0 = acc[ai][1][m][0] * W8_INV + bu0, u1 = acc[ai][1][m][1] * W8_INV + bu1;
                    float o[8];
#pragma unroll
                    for (int i = 0; i < 8; ++i) { float gt = i < 4 ? g0[i & 3] : g1[i & 3], up = i < 4 ? u0[i & 3] : u1[i & 3];
                        gt = fminf(gt, 7.f); up = fminf(fmaxf(up, -7.f), 7.f); o[i] = gt * sigmoidf_(1.702f * gt) * (up + 1.f); }
                    pc[h2].x = pk4_fp8(o[0], o[1], o[2], o[3]); pc[h2].y = pk4_fp8(o[4], o[5], o[6], o[7]); }
                unsigned char* rowx = ACT + (size_t)(row0 + ai * HALF + (2 * mp) * 16) * 1024 + j0;
                store16_pair(rowx, rowx + 16 * 1024, pc[0], pc[1], fq); }
    }
};
struct EpiDown {
    static constexpr int NSTORES = 8;
    static constexpr bool CONT64 = false;
    static constexpr bool DUAL = false;
    static constexpr bool PERM = true;
    const float* bd; unsigned char* O;
    __device__ __forceinline__ void operator()(const f32x4 (&acc)[2][2][4][2], const Unit& u, int wr, int wc, int fr, int fq) const {
        const int row0 = u.pm * BM + wr * 64 + fr, col0 = u.pn * BM + wc * 32 + 8 * fq;
        const float* bp = bd + (size_t)u.e * 1024 + col0;
#pragma unroll
        for (int bj = 0; bj < 2; ++bj) { const f32x4 b0 = *(const f32x4*)(bp + bj * HALF), b1 = *(const f32x4*)(bp + bj * HALF + 4);
#pragma unroll
            for (int ai = 0; ai < 2; ++ai)
#pragma unroll
                for (int mp = 0; mp < 2; ++mp) { unsigned char* rowx = O + (size_t)(row0 + ai * HALF + (2 * mp) * 16) * 1024 + col0 + bj * HALF; u32x2 a, b;
                    { const f32x4 v0 = acc[ai][bj][2 * mp][0] * W8_INV + b0, v1 = acc[ai][bj][2 * mp][1] * W8_INV + b1; a.x = pk4_fp8(v0[0], v0[1], v0[2], v0[3]); a.y = pk4_fp8(v1[0], v1[1], v1[2], v1[3]); }
                    { const f32x4 v0 = acc[ai][bj][2 * mp + 1][0] * W8_INV + b0, v1 = acc[ai][bj][2 * mp + 1][1] * W8_INV + b1; b.x = pk4_fp8(v0[0], v0[1], v0[2], v0[3]); b.y = pk4_fp8(v1[0], v1[1], v1[2], v1[3]); }
                    store16_pair(rowx, rowx + 16 * 1024, a, b, fq); } }
    }
};
}

#define XB_TMO      128
#define XB_XCNT(j)  (256  + 64 * (j))
#define XB_XSUB(j)  (1280 + 64 * (j))
#define XB_XGEN(j)  (2304 + 64 * (j))
#define XB_TOP      3328
#define XB_TOPGEN   3392
#define XCD_BAR_WORDS 3456
#define XB_SPIN_CAP (1u << 18)

__device__ __forceinline__ unsigned xb_ld(unsigned* p)              { return __hip_atomic_load(p, __ATOMIC_RELAXED, __HIP_MEMORY_SCOPE_AGENT); }
__device__ __forceinline__ unsigned xb_add(unsigned* p, unsigned v) { return __hip_atomic_fetch_add(p, v, __ATOMIC_RELAXED, __HIP_MEMORY_SCOPE_AGENT); }
__device__ __forceinline__ unsigned xb_xcc_id() { return (unsigned)__builtin_amdgcn_s_getreg((3 << 11) | 20) & 0xFu; }
#define XB_SPIN(cond, bar) do { unsigned _sp = 0; while (cond) { __builtin_amdgcn_s_sleep(1); \
    if ((++_sp & 255u) == 0u) { if (xb_ld(&(bar)[XB_TMO])) break; if (_sp > XB_SPIN_CAP) { atomicAdd(&(bar)[XB_TMO], 1u); break; } } } } while (0)

struct XcdBarrier { unsigned* bar; unsigned x; volatile LAS unsigned* st; };

__device__ __forceinline__ XcdBarrier xcd_barrier_post(unsigned* bar, volatile LAS unsigned* st) {
    XcdBarrier b; b.bar = bar; b.x = xb_xcc_id(); b.st = st;
    if (threadIdx.x == 0) (void)xb_add(&bar[XB_XCNT(b.x)], 1u);
    return b;
}
__device__ __forceinline__ void xcd_barrier_complete(unsigned* bar, unsigned x, unsigned& nloc, unsigned& nx) {
    const unsigned G = gridDim.x * gridDim.y * gridDim.z;
    unsigned sum, cnt, mine, sp = 0u;
    for (;;) {
        sum = 0u; cnt = 0u; mine = 0u;
#pragma unroll
        for (unsigned j = 0; j < 16; ++j) { const unsigned c = xb_ld(&bar[XB_XCNT(j)]); sum += c; cnt += (c > 0u) ? 1u : 0u; mine = (j == x) ? c : mine; }
        if (sum == G) break;
        __builtin_amdgcn_s_sleep(1);
        if ((++sp & 255u) == 0u) { if (xb_ld(&bar[XB_TMO])) break; if (sp > XB_SPIN_CAP) { atomicAdd(&bar[XB_TMO], 1u); break; } }
    }
    nloc = mine > 0u ? mine : 1u; nx = cnt > 0u ? cnt : 1u;
}
__device__ __forceinline__ void xcd_barrier(const XcdBarrier& b) {
    asm volatile("s_waitcnt vmcnt(0)" ::: "memory");
    __syncthreads();
    if (threadIdx.x == 0) {
        unsigned* bar = b.bar;
        __builtin_amdgcn_s_waitcnt(0);
        unsigned nloc = b.st[0], nx = b.st[1];
        if (nloc == 0u) { xcd_barrier_complete(bar, b.x, nloc, nx); b.st[0] = nloc; b.st[1] = nx; }
        const unsigned old = xb_add(&bar[XB_XSUB(b.x)], 1u);
        const unsigned gen = old / nloc;
        if (old + 1u == (gen + 1u) * nloc) {
            __builtin_amdgcn_fence(__ATOMIC_RELEASE, "agent");
            asm volatile("s_waitcnt vmcnt(0)" ::: "memory");
            const unsigned og = xb_add(&bar[XB_TOP], 1u);
            const unsigned tg = og / nx;
            if (og + 1u == (tg + 1u) * nx) xb_add(&bar[XB_TOPGEN], 1u);
            else XB_SPIN(xb_ld(&bar[XB_TOPGEN]) == tg, bar);
            __builtin_amdgcn_fence(__ATOMIC_ACQUIRE, "agent");
            xb_add(&bar[XB_XGEN(b.x)], 1u);
            asm volatile("s_waitcnt vmcnt(0)" ::: "memory");
        } else {
            XB_SPIN(xb_ld(&bar[XB_XGEN(b.x)]) == gen, bar);
            __builtin_amdgcn_fence(__ATOMIC_ACQUIRE, "agent");
            asm volatile("s_waitcnt vmcnt(0)" ::: "memory");
        }
    }
    __syncthreads();
}

struct Params { const float* in[27]; float* out; unsigned char* ws; int ph_lo, ph_hi; };
struct Frame {
    LAS unsigned char* lds; LAS unsigned* misc; int tid, lane, wave, bid, G;
    const float* const* in; float* out; unsigned char* ws; unsigned* ctl;
};
enum { I_X = 0, I_N1W, I_WIN, I_GW2, I_GB, I_GNW, I_CW, I_CB, I_FREQ, I_W1, I_B1, I_W2, I_B2, I_W3, I_DECAY, I_HBIAS, I_WBG, I_WBH, I_WOUT, I_N2W, I_RW, I_RB, I_WGU, I_BGU, I_WDN, I_BDN, I_NFW };

constexpr int CVT_SMALL = 352, CVT_ALL = 3424;
template <bool QUEUE>
__device__ void cvt_weights(const Frame& F, int it_lo, int it_hi) {
    constexpr int RSF = 513;
    LAS float* tile = (LAS float*)F.lds;
    for (int it0 = it_lo + F.bid; ; it0 += F.G) {
        int it = it0;
        if (QUEUE) { __syncthreads(); if (F.tid == 0) F.misc[MW_Q] = __hip_atomic_fetch_add(F.ctl + CW_CVTQ, 1u, __ATOMIC_RELAXED, __HIP_MEMORY_SCOPE_AGENT); __syncthreads(); it = it_lo + (int)F.misc[MW_Q]; }
        if (it >= it_hi) break;
        const float* src; int ld, kt, n0, kind; bf16_t* dst;
        bool f8 = it >= CVT_SMALL;
        if (it < 256) { kt = it & 15; n0 = (it >> 4) * 512; src = F.in[I_WIN]; ld = IN_TOTAL; kind = 1; dst = (bf16_t*)(F.ws + WS_WBIN); if (n0 >= 6144) { f8 = true; dst = (bf16_t*)(F.ws + WS_WBIN8 - (size_t)6144 * 1024); } }
        else if (it < 352) { const int j = it - 256, mat = j >> 5, rem = j & 31; kt = rem & 15; n0 = (rem >> 4) * 512; src = F.in[I_WBG + mat]; ld = 1024; kind = 0; dst = (bf16_t*)(F.ws + WS_WBBG + (size_t)mat * 2 * MiB); }
        else if (it < 2400) { const int j = it - 352, e = j >> 6, rem = j & 63; kt = rem & 15; n0 = (rem >> 4) * 512; src = F.in[I_WGU] + (size_t)e * 1024 * 2048; ld = 2048; kind = 2; dst = (bf16_t*)(F.ws + WS_WBGU + (size_t)e * 2048 * 1024); }
        else { const int j = it - 2400, e = j >> 5, rem = j & 31; kt = rem & 15; n0 = (rem >> 4) * 512; src = F.in[I_WDN] + (size_t)e * 1024 * 1024; ld = 1024; kind = 0; dst = (bf16_t*)(F.ws + WS_WBDN + (size_t)e * 1024 * 1024); }
        const int k0 = kt * 64;
        f32x4 v[16];
#pragma unroll
        for (int p = 0; p < 16; ++p) { const int e2 = F.tid + NTHR * p, k = e2 >> 7, nn = n0 + (e2 & 127) * 4; int sc = nn;
            if (kind == 1) sc = nn < 3072 ? nn : nn + 32;
            if (kind == 2) { const int pn = nn >> 8, x = nn & 255; sc = x < 128 ? 128 * pn + x : 1024 + 128 * pn + (x - 128); }
            v[p] = *(const f32x4*)(src + (size_t)(k0 + k) * ld + sc); }
        __syncthreads();
#pragma unroll
        for (int p = 0; p < 16; ++p) { const int e2 = F.tid + NTHR * p, k = e2 >> 7, n4 = (e2 & 127) * 4; LAS float* d = tile + k * RSF + n4; d[0] = v[p][0]; d[1] = v[p][1]; d[2] = v[p][2]; d[3] = v[p][3]; }
        __syncthreads();
#pragma unroll
        for (int q = 0; q < 8; ++q) { const int o = F.tid + NTHR * q, k8 = o & 7, n = o >> 3; const LAS float* t8 = tile + (8 * k8) * RSF + n;
            if (!f8) { u32x4 w; w.x = pk2(t8[0], t8[RSF]); w.y = pk2(t8[2 * RSF], t8[3 * RSF]); w.z = pk2(t8[4 * RSF], t8[5 * RSF]); w.w = pk2(t8[6 * RSF], t8[7 * RSF]);
                *(u32x4*)(dst + (size_t)(n0 + n) * 1024 + k0 + 8 * k8) = w; }
            else { u32x2 w; w.x = pk4_fp8(t8[0] * W8_SCALE, t8[RSF] * W8_SCALE, t8[2 * RSF] * W8_SCALE, t8[3 * RSF] * W8_SCALE); w.y = pk4_fp8(t8[4 * RSF] * W8_SCALE, t8[5 * RSF] * W8_SCALE, t8[6 * RSF] * W8_SCALE, t8[7 * RSF] * W8_SCALE);
                *(u32x2*)((unsigned char*)dst + (size_t)(n0 + n) * 1024 + k0 + 8 * k8) = w; } }
    }
    __syncthreads();
}

__device__ void p0_filter(const Frame& F) {
    LAS float* zf = (LAS float*)F.lds;
    LAS float* h1 = zf + 16 * 36;
    LAS float* h2 = h1 + 16 * 64;
    float* HRAW = (float*)(F.ws + WS_HRAW); float* SUMSQ = (float*)(F.ws + WS_SUMSQ);
    const float* fr = F.in[I_FREQ];
    for (int it = F.bid; it < 256; it += F.G) {
        const int t0 = it * 16;
        __syncthreads();
        for (int e = F.tid; e < 16 * 33; e += NTHR) { const int tt = e / 33, i = e % 33, t = t0 + tt; float v;
            if (i == 0) v = (float)((double)t / 4095.0);
            else { const int j = (i - 1) & 15; const double f = 1e-4 + (double)j * ((15.0 - 1e-4) / 15.0); double rev = (double)t * f / 4096.0; rev -= floor(rev);
                v = (i <= 16) ? __builtin_amdgcn_cosf((float)rev) : -__builtin_amdgcn_sinf((float)rev); }
            zf[tt * 36 + i] = v; }
        __syncthreads();
        for (int e = F.tid; e < 1024; e += NTHR) { const int tt = e >> 6, j = e & 63; float a = F.in[I_B1][j];
            for (int i = 0; i < 33; ++i) a += zf[tt * 36 + i] * F.in[I_W1][i * 64 + j];
            h1[tt * 64 + j] = sinf(fr[j] * a); }
        __syncthreads();
        for (int e = F.tid; e < 1024; e += NTHR) { const int tt = e >> 6, j = e & 63; float a = F.in[I_B2][j];
            for (int i = 0; i < 64; ++i) a += h1[tt * 64 + i] * F.in[I_W2][i * 64 + j];
            h2[tt * 64 + j] = sinf(fr[j] * a); }
        __syncthreads();
        float acc[16][4];
#pragma unroll
        for (int tt = 0; tt < 16; ++tt)
#pragma unroll
            for (int q = 0; q < 4; ++q) acc[tt][q] = 0.f;
        for (int k = 0; k < 64; ++k) { float w[4];
#pragma unroll
            for (int q = 0; q < 4; ++q) w[q] = F.in[I_W3][k * 2048 + q * 512 + F.tid];
#pragma unroll
            for (int tt = 0; tt < 16; ++tt) { const float hv = h2[tt * 64 + k];
#pragma unroll
                for (int q = 0; q < 4; ++q) acc[tt][q] += hv * w[q]; } }
#pragma unroll
        for (int q = 0; q < 4; ++q) { const int col = q * 512 + F.tid; const float dc = fabsf(F.in[I_DECAY][col]); float ss = 0.f;
#pragma unroll
            for (int tt = 0; tt < 16; ++tt) { const int t = t0 + tt; const float tn = (float)((double)t / 4095.0); const float v = acc[tt][q] * expf(-tn * dc);
                acc[tt][q] = v; if (!(col >= 1024 && t == 0)) ss += v * v; }
#pragma unroll
            for (int t4 = 0; t4 < 4; ++t4) *(f32x4*)(HRAW + (size_t)col * 4096 + t0 + 4 * t4) = (f32x4){acc[4 * t4][q], acc[4 * t4 + 1][q], acc[4 * t4 + 2][q], acc[4 * t4 + 3][q]};
            SUMSQ[(size_t)it * 2048 + col] = ss; }
    }
}

template <int MODE>
__device__ void norm_proj32(const Frame& F, const float* X, const float* nw, const float* Wsrc, int wld, bf16_t* XNout) {
    constexpr int ROWB = 2064;
    LAS unsigned char* thi = F.lds; LAS unsigned char* tlo = F.lds + 32 * ROWB;
    LAS float* part = (LAS float*)F.lds;
    LAS float* logit = (LAS float*)(F.lds + 32768);
    const int lane = F.lane, w = F.wave;
    bf16x8 Bhi[8], Blo[8];
    { const int c = lane & 31, hh = lane >> 5;
#pragma unroll
      for (int ks = 0; ks < 8; ++ks) { const int k0 = 128 * w + 16 * ks + 8 * hh;
#pragma unroll
        for (int j = 0; j < 8; ++j) { const float v = Wsrc[(size_t)(k0 + j) * wld + c]; const bf16_t h = f2bf(v); const bf16_t l = f2bf(v - bf2f(h)); Bhi[ks][j] = (short)h; Blo[ks][j] = (short)l; } } }
    f32x4 nwv[4];
#pragma unroll
    for (int q = 0; q < 4; ++q) nwv[q] = *(const f32x4*)(nw + 256 * q + 4 * lane);
    const int ngroups = T_ / 32, gpb = (ngroups + F.G - 1) / F.G;
    const int g_lo = F.bid * gpb, g_hi = (g_lo + gpb < ngroups) ? g_lo + gpb : ngroups;
    if (MODE == 1) { if (F.tid < 32) F.misc[MW_CNT + F.tid] = 0u; }
    __syncthreads();
    f32x4 xf[4][4]; u32x2 xh[4][4];
#define NP_ISSUE(GI) do { _Pragma("unroll") for (int i = 0; i < 4; ++i) { const size_t t = (size_t)(GI) * 32 + 4 * w + i; \
        _Pragma("unroll") for (int q = 0; q < 4; ++q) { if (MODE == 0) xf[i][q] = *(const f32x4*)(X + t * 1024 + 256 * q + 4 * lane); else xh[i][q] = *(const u32x2*)((const bf16_t*)X + t * 1024 + 256 * q + 4 * lane); } } } while (0)
    if (g_lo < g_hi) NP_ISSUE(g_lo);
    for (int gi = g_lo; gi < g_hi; ++gi) {
#pragma unroll
        for (int i = 0; i < 4; ++i) { const int tk = 4 * w + i; const size_t t = (size_t)gi * 32 + tk;
            f32x4 xv[4]; float ss = 0.f;
#pragma unroll
            for (int q = 0; q < 4; ++q) { if (MODE == 0) xv[q] = xf[i][q]; else { const u32x2 hb = xh[i][q]; xv[q] = (f32x4){bflo(hb.x), bfhi(hb.x), bflo(hb.y), bfhi(hb.y)}; }
                ss += xv[q][0] * xv[q][0] + xv[q][1] * xv[q][1] + xv[q][2] * xv[q][2] + xv[q][3] * xv[q][3]; }
            ss = wave_sum(ss); const float rstd = rsqrtf(ss * (1.f / 1024.f) + 1e-6f);
#pragma unroll
            for (int q = 0; q < 4; ++q) { const f32x4 v = xv[q] * rstd * nwv[q];
                bf16_t h[4], l[4];
#pragma unroll
                for (int e = 0; e < 4; ++e) { h[e] = f2bf(v[e]); l[e] = f2bf(v[e] - bf2f(h[e])); }
                u32x2 hw, lw; hw.x = (unsigned)h[0] | ((unsigned)h[1] << 16); hw.y = (unsigned)h[2] | ((unsigned)h[3] << 16); lw.x = (unsigned)l[0] | ((unsigned)l[1] << 16); lw.y = (unsigned)l[2] | ((unsigned)l[3] << 16);
                if (MODE == 0) { *(u32x2*)(XNout + t * 1024 + 256 * q + 4 * lane) = hw; *(unsigned*)(F.ws + WS_XN8 + t * 1024 + 256 * q + 4 * lane) = pk4_fp8(v[0], v[1], v[2], v[3]); } else *(unsigned*)((unsigned char*)XNout + t * 1024 + 256 * q + 4 * lane) = pk4_fp8(v[0], v[1], v[2], v[3]);
                *(LAS u32x2*)(thi + tk * ROWB + (256 * q + 4 * lane) * 2) = hw; *(LAS u32x2*)(tlo + tk * ROWB + (256 * q + 4 * lane) * 2) = lw; } }
        if (gi + 1 < g_hi) NP_ISSUE(gi + 1);
        __syncthreads();
        f32x16 acc;
#pragma unroll
        for (int i = 0; i < 16; ++i) acc[i] = 0.f;
        { const int r = lane & 31, hh = lane >> 5;
#pragma unroll
          for (int ks = 0; ks < 8; ++ks) { const int off = r * ROWB + (128 * w + 16 * ks + 8 * hh) * 2;
            const bf16x8 ah = *(const LAS bf16x8*)(thi + off), al = *(const LAS bf16x8*)(tlo + off);
            acc = __builtin_amdgcn_mfma_f32_32x32x16_bf16(ah, Bhi[ks], acc, 0, 0, 0);
            acc = __builtin_amdgcn_mfma_f32_32x32x16_bf16(al, Bhi[ks], acc, 0, 0, 0);
            acc = __builtin_amdgcn_mfma_f32_32x32x16_bf16(ah, Blo[ks], acc, 0, 0, 0); } }
        __syncthreads();
#pragma unroll
        for (int i = 0; i < 16; ++i) part[(w * 16 + i) * 64 + lane] = acc[i];
        __syncthreads();
        for (int o = F.tid; o < 1024; o += NTHR) { const int reg = o >> 6, ln = o & 63; float s = 0.f;
#pragma unroll
            for (int ww = 0; ww < 8; ++ww) s += part[(ww * 16 + reg) * 64 + ln];
            const int row = (reg & 3) + 8 * (reg >> 2) + 4 * (ln >> 5), e = ln & 31;
            if (MODE == 0) ((float*)(F.ws + WS_ALOW))[((size_t)gi * 32 + row) * 32 + e] = s; else logit[row * 33 + e] = s; }
        if (MODE == 1) {
            __syncthreads();
            if (F.tid < 32) { const int tk = F.tid; float v[32];
#pragma unroll
                for (int e = 0; e < 32; ++e) v[e] = logit[tk * 33 + e] + F.in[I_RB][e];
                unsigned taken = 0u; float tv[4]; int te[4];
#pragma unroll
                for (int k = 0; k < 4; ++k) { float best = -3.4e38f; int bi = 0;
#pragma unroll
                    for (int e = 0; e < 32; ++e) { const bool ok = !((taken >> e) & 1u) && (v[e] > best); best = ok ? v[e] : best; bi = ok ? e : bi; }
                    taken |= 1u << bi; tv[k] = best; te[k] = bi; }
                float ex[4], sum = 0.f;
#pragma unroll
                for (int k = 0; k < 4; ++k) { ex[k] = expf(tv[k] - tv[0]); sum += ex[k]; }
                const int tl = (gi - g_lo) * 32 + tk;
#pragma unroll
                for (int k = 0; k < 4; ++k) { const unsigned lp = atomicAdd((unsigned*)&F.misc[MW_CNT + te[k]], 1u);
                    F.misc[MW_SEL + (tl * 4 + k) * 3 + 0] = (unsigned)te[k]; F.misc[MW_SEL + (tl * 4 + k) * 3 + 1] = lp; F.misc[MW_SEL + (tl * 4 + k) * 3 + 2] = __float_as_uint(ex[k] / sum); } }
        }
        __syncthreads();
    }
    if (MODE == 1) {
        unsigned* gcount = F.ctl + CW_GCOUNT;
        if (F.tid < 32) F.misc[MW_BASE + F.tid] = __hip_atomic_fetch_add(gcount + F.tid, F.misc[MW_CNT + F.tid], __ATOMIC_RELAXED, __HIP_MEMORY_SCOPE_AGENT);
        __syncthreads();
        const int ntl = (g_hi - g_lo) * 32 * 4;
        for (int i = F.tid; i < ntl; i += NTHR) { const unsigned e = F.misc[MW_SEL + i * 3], lp = F.misc[MW_SEL + i * 3 + 1], wb = F.misc[MW_SEL + i * 3 + 2];
            const size_t gidx = (size_t)g_lo * 32 * 4 + i;
            const unsigned pos = F.misc[MW_BASE + e] + lp;
            ((int*)(F.ws + WS_EIDX))[gidx] = (int)e; ((int*)(F.ws + WS_POSE))[gidx] = (int)pos; ((unsigned*)(F.ws + WS_WGT))[gidx] = wb;
            ((int*)(F.ws + WS_LIST))[(size_t)e * T_ + pos] = (int)(gidx >> 2); }
        __syncthreads();
    }
}

#undef NP_ISSUE
__device__ void p1_rnorm(const Frame& F) {
    const float* SUMSQ = (const float*)(F.ws + WS_SUMSQ); float* RN = (float*)(F.ws + WS_RN);
    if (F.bid < 16 && F.tid < 64) { const int c = F.bid * 64 + F.tid; float sacc = 0.f;
        for (int i = 0; i < 256; ++i) sacc += SUMSQ[(size_t)i * 2048 + c] + SUMSQ[(size_t)i * 2048 + 1024 + c];
        RN[c] = rsqrtf(sacc + 1e-6f); }
}
__device__ void p2_gla_prep(const Frame& F) {
    LAS float* al = (LAS float*)F.lds; LAS float* tot = al + 64 * 32;
    const bf16_t* PQ = (const bf16_t*)(F.ws + WS_PQKV); const float* ALOW = (const float*)(F.ws + WS_ALOW);
    bf16_t* QT = (bf16_t*)(F.ws + WS_QT); bf16_t* KT = (bf16_t*)(F.ws + WS_KT); bf16_t* KE = (bf16_t*)(F.ws + WS_KE); float* DEC = (float*)(F.ws + WS_DEC);
    const int dk = F.tid & 127, tq = F.tid >> 7;
    const int pos = (dk & ~15) | swap23(dk & 15);
    for (int it = F.bid; it < 2048; it += F.G) {
        const int h = it & 3, n = (it >> 2) & 63, b = it >> 8; const size_t grow0 = (size_t)b * L_ + 64 * n;
        __syncthreads();
        { const int row = F.tid >> 3, c4 = (F.tid & 7) * 4; *(LAS f32x4*)(al + row * 32 + c4) = *(const f32x4*)(ALOW + (grow0 + row) * 32 + c4); }
        bf16_t qraw[16], kraw[16];
#pragma unroll
        for (int ii = 0; ii < 16; ++ii) { const size_t g = (grow0 + tq * 16 + ii) * 2048; qraw[ii] = PQ[g + h * 128 + dk]; kraw[ii] = PQ[g + 512 + h * 128 + dk]; }
        __syncthreads();
#pragma unroll
        for (int d = 0; d < 2; ++d) {
            float c[16];
            { float w2r[16]; const float gb = F.in[I_GB][d * 512 + h * 128 + dk];
#pragma unroll
              for (int r = 0; r < 16; ++r) w2r[r] = F.in[I_GW2][(d * 16 + r) * 512 + h * 128 + dk];
#pragma unroll
              for (int ii = 0; ii < 16; ii += 2) { const int i = tq * 16 + ii; f32x2 l2 = (f32x2){gb, gb};
#pragma unroll
                for (int r4 = 0; r4 < 16; r4 += 4) { const f32x4 a0 = *(const LAS f32x4*)(al + i * 32 + d * 16 + r4), a1 = *(const LAS f32x4*)(al + (i + 1) * 32 + d * 16 + r4);
#pragma unroll
                    for (int e = 0; e < 4; ++e) l2 = __builtin_elementwise_fma((f32x2){a0[e], a1[e]}, (f32x2){w2r[r4 + e], w2r[r4 + e]}, l2); }
                c[ii] = (fminf(l2[0], 0.f) - __logf(1.f + __expf(-fabsf(l2[0])))) * (1.f / 16.f); c[ii + 1] = (fminf(l2[1], 0.f) - __logf(1.f + __expf(-fabsf(l2[1])))) * (1.f / 16.f); } }
            if (d == 0) {
#pragma unroll
                for (int ii = 1; ii < 16; ++ii) c[ii] += c[ii - 1];
            } else {
#pragma unroll
                for (int ii = 14; ii >= 0; --ii) c[ii] += c[ii + 1];
            }
            __syncthreads();
            tot[tq * 128 + dk] = d == 0 ? c[15] : c[0];
            __syncthreads();
            float off = 0.f, total = 0.f;
#pragma unroll
            for (int t2 = 0; t2 < 4; ++t2) { const float a = tot[t2 * 128 + dk]; total += a; if (d == 0 ? (t2 < tq) : (t2 > tq)) off += a; }
            const size_t cb = (size_t)(((d * 8 + b) * 4 + h) * 64 + n);
            bf16_t* qd = QT + (cb * 64 + tq * 16) * 128 + pos; bf16_t* kd = KT + (cb * 64 + tq * 16) * 128 + pos;
            float ke[16];
            const float etot = __expf(total);
#pragma unroll
            for (int ii = 0; ii < 16; ++ii) { const float qv = bf2f(qraw[ii]), kv = bf2f(kraw[ii]); const float bb = c[ii] + off; const float kdec = kv * __expf(-bb);
                qd[ii * 128] = f2bf(qv * __expf(bb)); kd[ii * 128] = f2bf(kdec); ke[ii] = kdec * etot;
                if ((ii & 3) == 3) __builtin_amdgcn_sched_barrier(0); }
            { u32x4 w0, w1;
              w0.x = pk2(ke[0], ke[1]); w0.y = pk2(ke[2], ke[3]); w0.z = pk2(ke[8], ke[9]); w0.w = pk2(ke[10], ke[11]);
              w1.x = pk2(ke[4], ke[5]); w1.y = pk2(ke[6], ke[7]); w1.z = pk2(ke[12], ke[13]); w1.w = pk2(ke[14], ke[15]);
              u32x4* dd = (u32x4*)(KE + (cb * 128 + dk) * 64 + 16 * tq); dd[0] = w0; dd[1] = w1; }
            if (tq == 0) DEC[cb * 128 + dk] = etot;
            __builtin_amdgcn_sched_barrier(0);
        }
    }
}

constexpr int GS_QT = 0, GS_KT = 16384, GS_KE = 32768, GS_DEC = 49152, GS_SLOT = 50176, GS_V = 2 * GS_SLOT, GS_O = GS_V + 32768;
__device__ __forceinline__ void gla_dma(const Frame& F, LAS unsigned char* slot, __amdgpu_buffer_rsrc_t rR1, unsigned soffR1, const unsigned (&goff)[6], __amdgpu_buffer_rsrc_t rDEC, unsigned soffDEC, __amdgpu_buffer_rsrc_t rVT, unsigned soffVT, const unsigned (&voff)[4]) {
#pragma unroll
    for (int j = 0; j < 4; ++j) __builtin_amdgcn_raw_ptr_buffer_load_lds(rVT, (LAS void*)(F.lds + GS_V + F.wave * 4096 + j * 1024), 16, voff[j], (int)soffVT, 0, 0);
#pragma unroll
    for (int j = 0; j < 6; ++j) __builtin_amdgcn_raw_ptr_buffer_load_lds(rR1, (LAS void*)(slot + (F.wave * 6 + j) * 1024), 16, goff[j], (int)soffR1, 0, 0);
    if (F.wave == 0) __builtin_amdgcn_raw_ptr_buffer_load_lds(rDEC, (LAS void*)(slot + GS_DEC), 16, 16u * (unsigned)F.lane, (int)soffDEC, 0, 0);
}
__device__ void p3_gla_scan(const Frame& F) {
    if (F.bid >= 64) return;
    const int dir = F.bid & 1, h = (F.bid >> 1) & 3, b = F.bid >> 3, vb = F.wave, l31 = F.lane & 31, hh = F.lane >> 5;
    const __amdgpu_buffer_rsrc_t rR1 = __builtin_amdgcn_make_buffer_rsrc((void*)(F.ws + WS_R1), 0, 0x7FFFFFFF, 0x00020000), rVT = __builtin_amdgcn_make_buffer_rsrc((void*)(F.ws + WS_PQKV), 0, 0x7FFFFFFF, 0x00020000),
                                 rDEC = __builtin_amdgcn_make_buffer_rsrc((void*)(F.ws + WS_DEC), 0, 0x7FFFFFFF, 0x00020000);
    bf16_t* O = (bf16_t*)(F.ws + (dir ? WS_OB : WS_OF));
    unsigned goff[6], voff[4];
#pragma unroll
    for (int j = 0; j < 6; ++j) { const int pi = F.wave * 6 + j, arr = pi >> 4, p = pi & 15, l = F.lane;
        if (arr < 2) { const int row = 4 * p + (l >> 4), cpos = l & 15; goff[j] = (unsigned)arr * (64u << 20) + (unsigned)(row * 256 + 16 * (cpos ^ (row & 15))); }
        else { const int row = 8 * p + (l >> 3), cpos = l & 7; goff[j] = (128u << 20) + (unsigned)(row * 128 + 16 * (cpos ^ ((row >> 1) & 7))); } }
#pragma unroll
    for (int j = 0; j < 4; ++j) voff[j] = (unsigned)((16 * j + (F.lane >> 2)) * 4096 + (1024 + h * 256 + 32 * vb) * 2 + 16 * (F.lane & 3));
    f32x16 S[4];
#pragma unroll
    for (int kb = 0; kb < 4; ++kb)
#pragma unroll
        for (int i = 0; i < 16; ++i) S[kb][i] = 0.f;
    const size_t cbase = (size_t)(((dir * 8 + b) * 4 + h) * 64);
    { const int n0 = dir ? 63 : 0; const size_t cb = cbase + n0;
      gla_dma(F, F.lds, rR1, (unsigned)cb * 16384u, goff, rDEC, (unsigned)cb * 512u, rVT, (unsigned)(b * L_ + 64 * n0) * 4096u, voff); }
    asm volatile("s_waitcnt vmcnt(0)" ::: "memory");
    __builtin_amdgcn_s_barrier();
    const int r15 = l31 & 15;
    const LAS unsigned char* vcol = F.lds + GS_V + F.wave * 4096 + l31 * 2;
    const int vsw = (l31 >> 1) & 7;
    for (int cs = 0; cs < 64; ++cs) {
        const int n = dir ? 63 - cs : cs;
        bf16x8 vf[4];
#pragma unroll
        for (int s4 = 0; s4 < 4; ++s4) { unsigned short e[8];
#pragma unroll
            for (int i = 0; i < 4; ++i) { e[i] = *(const LAS bf16_t*)(vcol + (16 * s4 + 4 * hh + i) * 64); e[4 + i] = *(const LAS bf16_t*)(vcol + (16 * s4 + 8 + 4 * hh + i) * 64); }
            u32x4 w; w.x = e[0] | ((unsigned)e[1] << 16); w.y = e[2] | ((unsigned)e[3] << 16); w.z = e[4] | ((unsigned)e[5] << 16); w.w = e[6] | ((unsigned)e[7] << 16);
            vf[s4] = __builtin_bit_cast(bf16x8, w); }
        asm volatile("s_waitcnt lgkmcnt(0)" ::: "memory");
        __builtin_amdgcn_sched_barrier(0);
        if (cs + 1 < 64) { const int n1 = dir ? 62 - cs : cs + 1; const size_t cb = cbase + n1;
            gla_dma(F, F.lds + ((cs + 1) & 1) * GS_SLOT, rR1, (unsigned)cb * 16384u, goff, rDEC, (unsigned)cb * 512u, rVT, (unsigned)(b * L_ + 64 * n1) * 4096u, voff); }
        __builtin_amdgcn_sched_barrier(0);
        const LAS unsigned char* sl = F.lds + (cs & 1) * GS_SLOT;
        const LAS unsigned char* qrow = sl + GS_QT + l31 * 256; const LAS unsigned char* krow = sl + GS_KT + l31 * 256;
#pragma unroll
        for (int ib = 0; ib < 2; ++ib) {
            const bool has_off = dir ? (ib == 0) : (ib == 1);
            const int jo = dir ? 1 : 0;
            f32x16 sa, sb;
#pragma unroll
            for (int i = 0; i < 16; ++i) { sa[i] = 0.f; sb[i] = 0.f; }
            bf16x8 qn = *(const LAS bf16x8*)(qrow + ib * 8192 + 16 * (hh ^ r15)), kdn = *(const LAS bf16x8*)(krow + ib * 8192 + 16 * (hh ^ r15)), kon = kdn;
            if (has_off) kon = *(const LAS bf16x8*)(krow + jo * 8192 + 16 * (hh ^ r15));
#pragma unroll
            for (int s8 = 0; s8 < 8; ++s8) { const bf16x8 q = qn, kd = kdn, ko = kon;
                if (s8 < 7) { const int sw = 16 * ((2 * s8 + 2 + hh) ^ r15);
                    qn = *(const LAS bf16x8*)(qrow + ib * 8192 + sw); kdn = *(const LAS bf16x8*)(krow + ib * 8192 + sw);
                    if (has_off) kon = *(const LAS bf16x8*)(krow + jo * 8192 + sw); }
                sa = __builtin_amdgcn_mfma_f32_32x32x16_bf16(kd, q, sa, 0, 0, 0);
                if (has_off) sb = __builtin_amdgcn_mfma_f32_32x32x16_bf16(ko, q, sb, 0, 0, 0);
                __builtin_amdgcn_sched_barrier(0); }
            bf16x8 q0n = *(const LAS bf16x8*)(qrow + ib * 8192 + 16 * (hh ^ r15)), q1n = *(const LAS bf16x8*)(qrow + ib * 8192 + 16 * ((2 + hh) ^ r15));
#pragma unroll
            for (int reg = 0; reg < 16; ++reg) { const int jl = (reg & 3) + 8 * (reg >> 2) + 4 * hh; const bool keep = (dir == 0) ? (jl <= l31) : (jl > l31); sa[reg] = keep ? sa[reg] : 0.f; }
            f32x16 o;
#pragma unroll
            for (int i = 0; i < 16; ++i) o[i] = 0.f;
            o = __builtin_amdgcn_mfma_f32_32x32x16_bf16(pack8(sa, 0), vf[2 * ib], o, 0, 0, 0);
            o = __builtin_amdgcn_mfma_f32_32x32x16_bf16(pack8(sa, 8), vf[2 * ib + 1], o, 0, 0, 0);
            if (has_off) {
                const bf16x8 vo0 = dir ? vf[2] : vf[0], vo1 = dir ? vf[3] : vf[1];
                o = __builtin_amdgcn_mfma_f32_32x32x16_bf16(pack8(sb, 0), vo0, o, 0, 0, 0);
                o = __builtin_amdgcn_mfma_f32_32x32x16_bf16(pack8(sb, 8), vo1, o, 0, 0, 0); }
            __builtin_amdgcn_sched_barrier(0);
#pragma unroll
            for (int kb = 0; kb < 4; ++kb) { const bf16x8 q0 = q0n, q1 = q1n;
                if (kb < 3) { q0n = *(const LAS bf16x8*)(qrow + ib * 8192 + 16 * ((4 * kb + 4 + hh) ^ r15)); q1n = *(const LAS bf16x8*)(qrow + ib * 8192 + 16 * ((4 * kb + 6 + hh) ^ r15)); }
                o = __builtin_amdgcn_mfma_f32_32x32x16_bf16(q0, pack8(S[kb], 0), o, 0, 0, 0);
                o = __builtin_amdgcn_mfma_f32_32x32x16_bf16(q1, pack8(S[kb], 8), o, 0, 0, 0);
                __builtin_amdgcn_sched_barrier(0);
            }
            { LAS unsigned char* ost = F.lds + GS_O + F.wave * 2048;
#pragma unroll
              for (int reg = 0; reg < 16; ++reg) *(LAS bf16_t*)(ost + ((reg & 3) + 8 * (reg >> 2) + 4 * hh) * 64 + l31 * 2) = f2bf(o[reg]);
#pragma unroll
              for (int j = 0; j < 2; ++j) { const int pc = F.lane + 64 * j, row = pc >> 2, part = pc & 3;
                  *(u32x4*)(O + ((size_t)b * L_ + 64 * n + 32 * ib + row) * 1024 + h * 256 + 32 * vb + 8 * part) = *(const LAS u32x4*)(ost + row * 64 + part * 16); } }
            __builtin_amdgcn_sched_barrier(0);
        }
        {
          const LAS unsigned char* kerow = sl + GS_KE + l31 * 128; const LAS unsigned char* decp = sl + GS_DEC + 16 * hh;
          bf16x8 ken = *(const LAS bf16x8*)(kerow + 16 * (hh ^ vsw));
          f32x4 dn[4];
#pragma unroll
          for (int g = 0; g < 4; ++g) dn[g] = *(const LAS f32x4*)(decp + 32 * g);
#pragma unroll
          for (int kb = 0; kb < 4; ++kb) {
#pragma unroll
            for (int g = 0; g < 4; ++g)
#pragma unroll
                for (int e = 0; e < 4; ++e) S[kb][4 * g + e] *= dn[g][e];
            if (kb < 3) {
#pragma unroll
                for (int g = 0; g < 4; ++g) dn[g] = *(const LAS f32x4*)(decp + 128 * (kb + 1) + 32 * g); }
#pragma unroll
            for (int s4 = 0; s4 < 4; ++s4) { const bf16x8 kef = ken; const int st = kb * 4 + s4 + 1;
                if (st < 16) ken = *(const LAS bf16x8*)(kerow + (st >> 2) * 4096 + 16 * ((2 * (st & 3) + hh) ^ vsw));
                S[kb] = __builtin_amdgcn_mfma_f32_32x32x16_bf16(kef, vf[s4], S[kb], 0, 0, 0);
                __builtin_amdgcn_sched_barrier(0); }
          }
        }
        asm volatile("s_waitcnt vmcnt(4)\n\ts_waitcnt lgkmcnt(0)" ::: "memory");
        __builtin_amdgcn_s_barrier();
    }
    asm volatile("s_waitcnt vmcnt(0)" ::: "memory");
    __syncthreads();
}

__device__ void p4_conv_mfma(const Frame& F, int qsel) {
    constexpr int RS = 10560;
    LAS unsigned char* Rl = F.lds; LAS unsigned char* Zl = F.lds + 65536;
    const float* HRAWT = (const float*)(F.ws + WS_HRAW); const float* RN = (const float*)(F.ws + WS_RN); const bf16_t* XT = (const bf16_t*)(F.ws + WS_PHY); bf16_t* YT = (bf16_t*)(F.ws + WS_YT);
    const int lane = F.lane, g = F.wave >> 2, qp = F.wave & 3, q1 = 2 * qp + 1, cn = lane & 31, T1l = cn >> 3, b = cn & 7, hh = lane >> 5, r = lane & 31;
    __syncthreads();
    const int base_b = b * RS + 272 * T1l + 16 * hh;
    const int base_a = 2 * (4096 - 128 * (4 * q1 + 3) + 8 * hh - 4 * r);
    for (;;) {
        __syncthreads();
        if (F.tid == 0) F.misc[MW_Q] = __hip_atomic_fetch_add(F.ctl + CW_CONVQ + 64 * qsel, 1u, __ATOMIC_RELAXED, __HIP_MEMORY_SCOPE_AGENT);
        __syncthreads();
        const int cq = (int)F.misc[MW_Q];
        if (cq >= (PROBE_PHASE == 32 ? 2048 : 1024)) break;
        const int c = cq & 1023;
        for (int ch = F.tid; ch < 768; ch += NTHR) { const int bb = ch / 96, k = ch % 96, idx8 = k < 48 ? 8 * k : 4480 + 8 * (k - 48);
            *(LAS u32x4*)(Zl + bb * RS + 2 * idx8 + 16 * (idx8 >> 7)) = (u32x4){0u, 0u, 0u, 0u}; }
        { int ln; asm volatile("v_mbcnt_lo_u32_b32 %0, -1, 0\n\tv_mbcnt_hi_u32_b32 %0, -1, %0" : "=v"(ln)); const int tq = F.wave * 64 + ln;
          const float* gfw = HRAWT + (size_t)c * 4096; const float* gbw = HRAWT + (size_t)(1024 + c) * 4096; const float rn = RN[c], bi = F.in[I_HBIAS][c];
          f32x4 vf[2], vb[2];
#pragma unroll
          for (int k = 0; k < 2; ++k) { vf[k] = *(const f32x4*)(gfw + (tq + NTHR * k) * 4); vb[k] = *(const f32x4*)(gbw + (tq + NTHR * k) * 4); }
          { const bf16_t* x1p = XT + (size_t)c * T_; const bf16_t* vvp = XT + (size_t)(1024 + c) * T_;
            const float* cw = F.in[I_CW]; const float* cb = F.in[I_CB];
            const float wa0 = cw[1024 + c], wa1 = cw[3072 + 1024 + c], wa2 = cw[2 * 3072 + 1024 + c], ba = cb[1024 + c];
            const float wv0 = cw[2048 + c], wv1 = cw[3072 + 2048 + c], wv2 = cw[2 * 3072 + 2048 + c], bv = cb[2048 + c];
            u32x4 xr[8], vr[8];
            LAS unsigned* edgeF = (LAS unsigned*)(Zl + 8 * RS); LAS unsigned* edgeL = edgeF + 64;
#pragma unroll
            for (int k = 0; k < 8; ++k) { const size_t g0 = (size_t)k * 4096 + 8 * tq;
                xr[k] = *(const u32x4*)(x1p + g0); vr[k] = *(const u32x4*)(vvp + g0); }
            if (ln == 0) {
#pragma unroll
                for (int k = 0; k < 8; ++k) edgeF[k * 8 + F.wave] = (xr[k].x & 0xffffu) | (vr[k].x << 16); }
            if (ln == 63) {
#pragma unroll
                for (int k = 0; k < 8; ++k) edgeL[k * 8 + F.wave] = (xr[k].w >> 16) | (vr[k].w & 0xffff0000u); }
            __syncthreads();
            const int wl = F.wave > 0 ? F.wave - 1 : 0, wn = F.wave < 7 ? F.wave + 1 : 7;
#pragma unroll
            for (int k = 0; k < 8; ++k) { const int bb = k, idx = 8 * tq + 384;
                const unsigned xlu = __shfl_up(xr[k].w, 1), xru = __shfl_down(xr[k].x, 1), vlu = __shfl_up(vr[k].w, 1), vru = __shfl_down(vr[k].x, 1);
                const unsigned el = F.wave > 0 ? edgeL[k * 8 + wl] : 0u, ef = F.wave < 7 ? edgeF[k * 8 + wn] : 0u;
                float xe[10], ve[10];
                xe[0] = ln == 0 ? __uint_as_float(el << 16) : bfhi(xlu); ve[0] = ln == 0 ? __uint_as_float(el & 0xffff0000u) : bfhi(vlu);
                xe[9] = ln == 63 ? __uint_as_float(ef << 16) : bflo(xru); ve[9] = ln == 63 ? __uint_as_float(ef & 0xffff0000u) : bflo(vru);
                xe[1] = bflo(xr[k].x); xe[2] = bfhi(xr[k].x); xe[3] = bflo(xr[k].y); xe[4] = bfhi(xr[k].y); xe[5] = bflo(xr[k].z); xe[6] = bfhi(xr[k].z); xe[7] = bflo(xr[k].w); xe[8] = bfhi(xr[k].w);
                ve[1] = bflo(vr[k].x); ve[2] = bfhi(vr[k].x); ve[3] = bflo(vr[k].y); ve[4] = bfhi(vr[k].y); ve[5] = bflo(vr[k].z); ve[6] = bfhi(vr[k].z); ve[7] = bflo(vr[k].w); ve[8] = bfhi(vr[k].w);
                float zz[8];
#pragma unroll
                for (int e = 0; e < 8; ++e) zz[e] = (wv0 * ve[e] + wv1 * ve[e + 1] + wv2 * ve[e + 2] + bv) * (wa0 * xe[e] + wa1 * xe[e + 1] + wa2 * xe[e + 2] + ba);
                u32x4 zw; zw.x = pk2(zz[0], zz[1]); zw.y = pk2(zz[2], zz[3]); zw.z = pk2(zz[4], zz[5]); zw.w = pk2(zz[6], zz[7]);
                *(LAS u32x4*)(Zl + bb * RS + 2 * idx + 16 * (idx >> 7)) = zw; } }
#pragma unroll
          for (int k = 0; k < 2; ++k)
#pragma unroll
            for (int e = 0; e < 4; ++e) { const int d = (tq + NTHR * k) * 4 + e; float v = vf[k][e] * rn; if (d == 0) v += bi; const bf16_t hv = f2bf(v), hb = f2bf(vb[k][e] * rn);
#pragma unroll
                for (int m = 0; m < 4; ++m) { *(LAS bf16_t*)(Rl + m * 16384 + 2 * (m + 4096 - d)) = hv;
                    const int ib = m + 4096 + d; if (d >= 1 && ib < 8192) *(LAS bf16_t*)(Rl + m * 16384 + 2 * ib) = hb; } } }
        __syncthreads();
        f32x16 acc0[4], acc1[4];
#pragma unroll
        for (int m = 0; m < 4; ++m)
#pragma unroll
            for (int i = 0; i < 16; ++i) { acc0[m][i] = 0.f; acc1[m][i] = 0.f; }
#define CONV_STEPS(JLO, JHI, DO0, DO1) do { const LAS unsigned char* pa = Rl + base_a + 32 * (JLO); const LAS unsigned char* pb1 = Zl + base_b + 272 * ((JLO) >> 3); \
        for (int jo = (JLO); jo < (JHI); jo += 8) { \
            _Pragma("unroll") for (int ki = 0; ki < 8; ++ki) { \
                bf16x8 bf1, bf0; if (DO1) bf1 = *(const LAS bf16x8*)(pb1 + 32 * ki); if (DO0) bf0 = *(const LAS bf16x8*)(pb1 - 1088 + 32 * ki); \
                _Pragma("unroll") for (int m = 0; m < 4; ++m) { const u32x2 lo = *(const LAS u32x2*)(pa + m * 16384 + 32 * ki), hi = *(const LAS u32x2*)(pa + m * 16384 + 32 * ki + 8); \
                    u32x4 av; av.x = lo.x; av.y = lo.y; av.z = hi.x; av.w = hi.y; const bf16x8 af = __builtin_bit_cast(bf16x8, av); \
                    if (DO1) acc1[m] = __builtin_amdgcn_mfma_f32_32x32x16_bf16(af, bf1, acc1[m], 0, 0, 0); \
                    if (DO0) acc0[m] = __builtin_amdgcn_mfma_f32_32x32x16_bf16(af, bf0, acc0[m], 0, 0, 0); } } \
            pa += 256; pb1 += 272; } } while (0)
        if (g == 0) { CONV_STEPS(0, 32, false, true); CONV_STEPS(32, 160, true, true); }
        else        { CONV_STEPS(160, 280, true, true); CONV_STEPS(280, 312, true, false); }
#undef CONV_STEPS
        __syncthreads();
        { LAS unsigned char* part = F.lds + qp * 32768 + lane * 16;
          if (g == 1) {
#pragma unroll
            for (int m = 0; m < 4; ++m)
#pragma unroll
                for (int v4 = 0; v4 < 4; ++v4) { *(LAS f32x4*)(part + ((0 * 4 + m) * 4 + v4) * 1024) = (f32x4){acc0[m][4 * v4], acc0[m][4 * v4 + 1], acc0[m][4 * v4 + 2], acc0[m][4 * v4 + 3]};
                    *(LAS f32x4*)(part + ((1 * 4 + m) * 4 + v4) * 1024) = (f32x4){acc1[m][4 * v4], acc1[m][4 * v4 + 1], acc1[m][4 * v4 + 2], acc1[m][4 * v4 + 3]}; } }
          __syncthreads();
          if (g == 0) {
#pragma unroll
            for (int m = 0; m < 4; ++m)
#pragma unroll
                for (int v4 = 0; v4 < 4; ++v4) { const f32x4 p0 = *(const LAS f32x4*)(part + ((0 * 4 + m) * 4 + v4) * 1024), p1 = *(const LAS f32x4*)(part + ((1 * 4 + m) * 4 + v4) * 1024);
#pragma unroll
                    for (int e = 0; e < 4; ++e) { acc0[m][4 * v4 + e] += p0[e]; acc1[m][4 * v4 + e] += p1[e]; } } }
          __syncthreads(); }
        if (g == 0) {
#pragma unroll
            for (int reg = 0; reg < 16; ++reg) { const int rp = (reg & 3) + 8 * (reg >> 2) + 4 * hh;
                { const int idx = 128 * (4 * (q1 - 1) + T1l) + 4 * rp + 384; u32x2 wv; wv.x = pk2(acc0[0][reg], acc0[1][reg]); wv.y = pk2(acc0[2][reg], acc0[3][reg]); *(LAS u32x2*)(Zl + b * RS + 2 * idx + 16 * (idx >> 7)) = wv; }
                { const int idx = 128 * (4 * q1 + T1l) + 4 * rp + 384; u32x2 wv; wv.x = pk2(acc1[0][reg], acc1[1][reg]); wv.y = pk2(acc1[2][reg], acc1[3][reg]); *(LAS u32x2*)(Zl + b * RS + 2 * idx + 16 * (idx >> 7)) = wv; } } }
        __syncthreads();
#pragma unroll
        for (int k = 0; k < 8; ++k) { const int chunk = F.tid + NTHR * k, bb = chunk >> 9, idx = (chunk & 511) * 8 + 384;
            *(u32x4*)(YT + ((size_t)c * 8 + bb) * 4096 + (chunk & 511) * 8) = *(const LAS u32x4*)(Zl + bb * RS + 2 * idx + 16 * (idx >> 7)); }
    }
    __syncthreads();
}

__device__ void p5_finish(const Frame& F) {
    const bf16_t* OF = (const bf16_t*)(F.ws + WS_OF); const bf16_t* OB = (const bf16_t*)(F.ws + WS_OB); const bf16_t* PR = (const bf16_t*)(F.ws + WS_PR);
    bf16_t* OG = (bf16_t*)(F.ws + WS_OGLA);
    const int lane = F.lane;
    const f32x4 gn = *(const f32x4*)(F.in[I_GNW] + 4 * lane);
    for (int row0 = (F.bid * 8 + F.wave) * 4; row0 < T_ * 4; row0 += F.G * 8 * 4) {
        u32x2 a[4], b[4], r[4];
#pragma unroll
        for (int j = 0; j < 4; ++j) { const size_t o = (size_t)(row0 + j) * 256 + 4 * lane; a[j] = *(const u32x2*)(OF + o); b[j] = *(const u32x2*)(OB + o); r[j] = *(const u32x2*)(PR + o); }
#pragma unroll
        for (int j = 0; j < 4; ++j) { const size_t o = (size_t)(row0 + j) * 256 + 4 * lane;
            float v[4] = {bflo(a[j].x) + bflo(b[j].x), bfhi(a[j].x) + bfhi(b[j].x), bflo(a[j].y) + bflo(b[j].y), bfhi(a[j].y) + bfhi(b[j].y)};
            float ss = wave_sum(v[0] * v[0] + v[1] * v[1] + v[2] * v[2] + v[3] * v[3]);
            const float rstd = rsqrtf(ss * (1.f / 256.f) + 1e-6f);
            const float rr[4] = {bflo(r[j].x), bfhi(r[j].x), bflo(r[j].y), bfhi(r[j].y)};
            float ov[4];
#pragma unroll
            for (int e = 0; e < 4; ++e) { const float on = v[e] * rstd * gn[e]; ov[e] = on * (rr[e] * sigmoidf_(rr[e])); }
            u32x2 w; w.x = pk2(ov[0], ov[1]); w.y = pk2(ov[2], ov[3]); *(u32x2*)(OG + o) = w; }
    }
    { constexpr int RSZ = 2052; LAS unsigned char* zt = F.lds;
      const bf16_t* YT = (const bf16_t*)(F.ws + WS_YT); const bf16_t* X0C = (const bf16_t*)(F.ws + WS_X0C); bf16_t* OH = (bf16_t*)(F.ws + WS_OHY);
      for (int it = F.bid; it < T_ / 64; it += F.G) {
        const int bq = (it * 64) >> 12, tq0 = (it * 64) & 4095;
        __syncthreads();
        for (int o = F.tid; o < 8192; o += NTHR) { const int part = (o >> 3) & 7, c = (o & 7) + 8 * (o >> 6);
            const u32x4 wv = *(const u32x4*)(YT + ((size_t)c * 8 + bq) * 4096 + tq0 + 8 * part);
            const unsigned ww[4] = {wv.x, wv.y, wv.z, wv.w};
#pragma unroll
            for (int k = 0; k < 8; ++k) *(LAS bf16_t*)(zt + (8 * part + k) * RSZ + c * 2) = (bf16_t)((k & 1) ? (ww[k >> 1] >> 16) : (ww[k >> 1] & 0xffffu)); }
        __syncthreads();
        for (int o = F.tid; o < 64 * 256; o += NTHR) { const int tl = o >> 8, c0 = (o & 255) * 4; const size_t t = (size_t)it * 64 + tl;
            const LAS unsigned* zp = (const LAS unsigned*)(zt + tl * RSZ + c0 * 2); const unsigned y0 = zp[0], y1 = zp[1];
            const int tt = (int)(t & 4095); u32x2 xp, xn; xp.x = 0u; xp.y = 0u; xn = xp;
            const u32x2 xc = *(const u32x2*)(X0C + t * 1024 + c0); if (tt > 0) xp = *(const u32x2*)(X0C + (t - 1) * 1024 + c0); if (tt < 4095) xn = *(const u32x2*)(X0C + (t + 1) * 1024 + c0);
            const f32x4 w0 = *(const f32x4*)(F.in[I_CW] + c0), w1 = *(const f32x4*)(F.in[I_CW] + 3072 + c0), w2 = *(const f32x4*)(F.in[I_CW] + 6144 + c0), bz = *(const f32x4*)(F.in[I_CB] + c0);
            const float u0 = w0[0] * bflo(xp.x) + w1[0] * bflo(xc.x) + w2[0] * bflo(xn.x) + bz[0], u1 = w0[1] * bfhi(xp.x) + w1[1] * bfhi(xc.x) + w2[1] * bfhi(xn.x) + bz[1];
            const float u2 = w0[2] * bflo(xp.y) + w1[2] * bflo(xc.y) + w2[2] * bflo(xn.y) + bz[2], u3 = w0[3] * bfhi(xp.y) + w1[3] * bfhi(xc.y) + w2[3] * bfhi(xn.y) + bz[3];
            u32x2 wv; wv.x = pk2(bflo(y0) * u0, bfhi(y0) * u1); wv.y = pk2(bflo(y1) * u2, bfhi(y1) * u3);
            *(u32x2*)(OH + t * 1024 + c0) = wv; }
      }
      __syncthreads(); }
}

__device__ void moe_offsets(const Frame& F) {
    __syncthreads();
    if (F.tid == 0) { unsigned rb = 0, rt = 0; LAS unsigned char* te = (LAS unsigned char*)(F.misc + MW_TILE);
        for (int e = 0; e < 32; ++e) { const unsigned c = __hip_atomic_load(F.ctl + CW_GCOUNT + e, __ATOMIC_RELAXED, __HIP_MEMORY_SCOPE_AGENT); const unsigned nt = (c + 255u) >> 8;
            F.misc[MW_ROWB + e] = rb; for (unsigned i = 0; i < nt; ++i) te[rt + i] = (unsigned char)e; rt += nt; rb += nt * 256u; }
        F.misc[MW_ROWB + 32] = rb; F.misc[MW_RT] = rt; }
    __syncthreads();
}
constexpr int GT_TAB = 131072, GT_SLOT = 131072 + 17 * 1024;
__device__ void moe_gather_tables(const Frame& F, int nN) {
    LAS int* tab = (LAS int*)(F.lds + GT_TAB); LAS unsigned char* slot = F.lds + GT_SLOT; LAS int* pmof = (LAS int*)(F.lds + GT_SLOT + 544);
    const int RT = (int)F.misc[MW_RT];
    for (int i = F.tid; i < 544; i += NTHR) slot[i] = 0xFF;
    __syncthreads();
    if (F.tid == 0) { int ns = 0; const int nwg = RT * nN;
        for (int i = 0; ; ++i) { const long Lq = (long)i * F.G + F.bid; if (Lq >= nwg) break; int pm, pn; pg8::tile_of((int)Lq, RT, nN, pm, pn); if (slot[pm] == 0xFF) { const int sl = ns < 16 ? ns : 16; slot[pm] = (unsigned char)sl; pmof[sl] = pm; ++ns; } }
        F.misc[MW_Q] = (unsigned)(ns < 17 ? ns : 17); }
    __syncthreads();
    const int ns = (int)F.misc[MW_Q]; const int* LIST = (const int*)(F.ws + WS_LIST); const LAS unsigned char* te = (const LAS unsigned char*)(F.misc + MW_TILE);
    for (int i = F.tid; i < ns * 256; i += NTHR) { const int sl = i >> 8, r = i & 255, pm = pmof[sl], e = te[pm];
        const int pos = pm * 256 + r - (int)F.misc[MW_ROWB + e];
        const int cnt = (int)__hip_atomic_load(F.ctl + CW_GCOUNT + e, __ATOMIC_RELAXED, __HIP_MEMORY_SCOPE_AGENT);
        tab[i] = pos < cnt ? LIST[(size_t)e * T_ + pos] : 0; }
    __syncthreads();
}

__device__ void p12_combine(const Frame& F) {
    const unsigned char* OUTP = F.ws + WS_OUTP;                       const int* EIDX = (const int*)(F.ws + WS_EIDX); const int* POSE = (const int*)(F.ws + WS_POSE); const float* WGT = (const float*)(F.ws + WS_WGT);
    const int lane = F.lane;
    f32x4 nf[4];
#pragma unroll
    for (int q = 0; q < 4; ++q) nf[q] = *(const f32x4*)(F.in[I_NFW] + 256 * q + 4 * lane);
    for (int t = F.bid * 8 + F.wave; t < T_; t += F.G * 8) {
        f32x4 hv[4];
#pragma unroll
        for (int q = 0; q < 4; ++q) { const u32x2 hb = *(const u32x2*)((const bf16_t*)(F.ws + WS_H) + (size_t)t * 1024 + 256 * q + 4 * lane); hv[q] = (f32x4){bflo(hb.x), bfhi(hb.x), bflo(hb.y), bfhi(hb.y)}; }
#pragma unroll
        for (int k = 0; k < 4; ++k) { const int d = (int)F.misc[MW_ROWB + EIDX[t * 4 + k]] + POSE[t * 4 + k]; const float wk = WGT[t * 4 + k];
#pragma unroll
            for (int q = 0; q < 4; ++q) { const unsigned v = *(const unsigned*)(OUTP + (size_t)d * 1024 + 256 * q + 4 * lane);
                const f32x2 lo = __builtin_amdgcn_cvt_pk_f32_fp8((int)v, false), hi = __builtin_amdgcn_cvt_pk_f32_fp8((int)v, true);
                hv[q][0] += wk * lo[0]; hv[q][1] += wk * lo[1]; hv[q][2] += wk * hi[0]; hv[q][3] += wk * hi[1]; } }
        float ss = 0.f;
#pragma unroll
        for (int q = 0; q < 4; ++q) ss += hv[q][0] * hv[q][0] + hv[q][1] * hv[q][1] + hv[q][2] * hv[q][2] + hv[q][3] * hv[q][3];
        ss = wave_sum(ss); const float rstd = rsqrtf(ss * (1.f / 1024.f) + 1e-6f);
#pragma unroll
        for (int q = 0; q < 4; ++q) *(f32x4*)(F.out + (size_t)t * 1024 + 256 * q + 4 * lane) = hv[q] * rstd * nf[q];
    }
}

#define PHASE_FN __device__ __forceinline__ void
__device__ __forceinline__ Frame fresh(const Frame& F0) { Frame F = F0; int l; asm volatile("v_mbcnt_lo_u32_b32 %0, -1, 0\n\tv_mbcnt_hi_u32_b32 %0, -1, %0" : "=v"(l)); F.lane = l; F.tid = F0.wave * 64 + l; return F; }
PHASE_FN ph0(const Frame& F0) { const Frame F = fresh(F0);
    cvt_weights<false>(F, 0, CVT_SMALL); __syncthreads();
    p0_filter(F); __syncthreads();
    norm_proj32<0>(F, F.in[I_X], F.in[I_N1W], F.in[I_WIN] + 3072, IN_TOTAL, (bf16_t*)(F.ws + WS_XN));
}
PHASE_FN ph1(const Frame& F0) { const Frame F = fresh(F0);
    using namespace pg8;
    p1_rnorm(F);
    { StaticOrder S; S.init((const bf16_t*)(F.ws + WS_XN), (const bf16_t*)(F.ws + WS_WBIN), T_, 4096, 1024, F.G, F.bid);
      EpiInProj E{(bf16_t*)(F.ws + WS_PQKV), (bf16_t*)(F.ws + WS_PR), (bf16_t*)(F.ws + WS_PHY), (bf16_t*)(F.ws + WS_X0C), 0};
      gemm_phase<EpiInProj, StaticOrder>(F.lds, S, E); }
    { StaticOrder S; S.init((const bf16_t*)(F.ws + WS_XN), (const bf16_t*)(F.ws + WS_WBIN) + (size_t)4096 * 1024, T_, 2048, 1024, F.G, F.bid);
      EpiHyT E{(bf16_t*)(F.ws + WS_PHY)};
      gemm_phase<EpiHyT, StaticOrder>(F.lds, S, E); }
}
#ifndef P2_MASK
#define P2_MASK 7
#endif
PHASE_FN ph2(const Frame& F0) { const Frame F = fresh(F0); __syncthreads();
    if (P2_MASK & 4) p2_gla_prep(F); if (PROBE_PHASE == 22) { __syncthreads(); p2_gla_prep(F); } }
PHASE_FN ph3(const Frame& F0, int rep) { const Frame F = fresh(F0); p3_gla_scan(F); __syncthreads(); if (PROBE_PHASE == 30) { p3_gla_scan(F); __syncthreads(); }
    p4_conv_mfma(F, rep); if (PROBE_PHASE == 31) p4_conv_mfma(F, 1);
    { const Frame F2 = fresh(F0); cvt_weights<true>(F2, CVT_SMALL, CVT_ALL); } }
PHASE_FN ph4(const Frame& F0) { const Frame F = fresh(F0);
    using namespace pg8;
    p5_finish(F); __syncthreads(); if (PROBE_PHASE == 40) { p5_finish(F); __syncthreads(); }
    StaticOrder S; S.init(F.ws + WS_XN8, F.ws + WS_WBIN8, T_, 2048, 1024, F.G, F.bid, 1);
    EpiGates8 E{F.ws + WS_PG};
    gemm_phase<EpiGates8, StaticOrder, true>(F.lds, S, E);
}
PHASE_FN ph5(const Frame& F0) { const Frame F = fresh(F0);
    using namespace pg8;
    DualOrder S; S.init((const bf16_t*)(F.ws + WS_OGLA), (const bf16_t*)(F.ws + WS_WBBG), (unsigned)(WS_OHY - WS_OGLA), (unsigned)(WS_WBBH - WS_WBBG), T_, 1024, 1024, F.G, F.bid);
    EpiMerge E{F.ws + WS_PG, (bf16_t*)(F.ws + WS_MERGED)};
    gemm_phase<EpiMerge, DualOrder>(F.lds, S, E);
}
PHASE_FN ph6(const Frame& F0) { const Frame F = fresh(F0);
    using namespace pg8;
    StaticOrder S; S.init((const bf16_t*)(F.ws + WS_MERGED), (const bf16_t*)(F.ws + WS_WBOUT), T_, 1024, 1024, F.G, F.bid);
    EpiResid E{F.in[I_X], (bf16_t*)(F.ws + WS_H)};
    gemm_phase<EpiResid, StaticOrder>(F.lds, S, E);
}
PHASE_FN ph7(const Frame& F0) { const Frame F = fresh(F0); norm_proj32<1>(F, (const float*)(F.ws + WS_H), F.in[I_N2W], F.in[I_RW], 32, (bf16_t*)(F.ws + WS_HN)); }
PHASE_FN ph9(const Frame& F0) { const Frame F = fresh(F0);
    using namespace pg8;
    moe_offsets(F); moe_gather_tables(F, 8);
    GatherOrder S; S.init(F.ws + WS_HN, F.ws + WS_WBGU, (const LAS unsigned char*)(F.misc + MW_TILE), (const LAS unsigned char*)(F.lds + GT_SLOT), (const LAS int*)(F.lds + GT_TAB),
                          (int)F.misc[MW_RT], 2048, 1024, 1, F.G, F.bid);
    EpiGateUp E{F.in[I_BGU], F.ws + WS_ACT};
    gemm_phase<EpiGateUp, GatherOrder, true>(F.lds, S, E);
}
PHASE_FN ph10(const Frame& F0) { const Frame F = fresh(F0);
    using namespace pg8;
    moe_offsets(F);
    GroupedOrder S; S.init(F.ws + WS_ACT, F.ws + WS_WBDN, (const LAS unsigned char*)(F.misc + MW_TILE), (int)F.misc[MW_RT], 1024, 1024, 1, F.G, F.bid);
    EpiDown E{F.in[I_BDN], F.ws + WS_OUTP};
    gemm_phase<EpiDown, GroupedOrder, true>(F.lds, S, E);
}
PHASE_FN ph11(const Frame& F0) { const Frame F = fresh(F0); moe_offsets(F); p12_combine(F); }

constexpr int N_PHASES = 12;
__global__ void __launch_bounds__(NTHR, 2) hybrid_fwd(Params P) {
    extern __shared__ __attribute__((aligned(16))) unsigned char lds_raw[];
    Frame F;
    F.lds = (LAS unsigned char*)lds_raw; F.misc = (LAS unsigned*)(F.lds + MISC_OFF);
    F.tid = threadIdx.x; F.lane = F.tid & 63; F.wave = __builtin_amdgcn_readfirstlane(F.tid >> 6); F.bid = blockIdx.x; F.G = gridDim.x;
    F.in = P.in; F.out = P.out; F.ws = P.ws; F.ctl = (unsigned*)(P.ws + WS_CTL);
    if (F.tid < 4) F.misc[F.tid] = 0u;
    __syncthreads();
    XcdBarrier bar; bar.bar = F.ctl + CW_BAR; bar.x = 0; bar.st = nullptr;
    const int lo = P.ph_lo, hi = P.ph_hi;
    if (hi - lo > 1) bar = xcd_barrier_post(F.ctl + CW_BAR, (volatile LAS unsigned*)F.misc);
#ifndef ONLY_PHASE
#define ONLY_PHASE -1
#endif
#define IN(k) (lo <= (k) && (k) < hi && (ONLY_PHASE < 0 || ONLY_PHASE == (k)))
#define SEAM(k) do { if (IN(k) && IN((k) + 1)) xcd_barrier(bar); else __syncthreads(); } while (0)

    if (IN(0)) { ph0(F); if (PROBE_PHASE == 0) ph0(F); }
    SEAM(0);
    if (IN(1)) { ph1(F); if (PROBE_PHASE == 1) ph1(F); }
    SEAM(1);
    if (IN(2)) { ph2(F); if (PROBE_PHASE == 2) ph2(F); }
    SEAM(2);
    if (IN(3)) { ph3(F, 0); if (PROBE_PHASE == 3) ph3(F, 1); }
    SEAM(3);
    if (IN(4)) { ph4(F); if (PROBE_PHASE == 4) ph4(F); }
    SEAM(4);
    if (IN(5)) { ph5(F); if (PROBE_PHASE == 5) ph5(F); }
    SEAM(5);
    if (IN(6)) { ph6(F); if (PROBE_PHASE == 6) ph6(F); }
    SEAM(6);
    if (IN(7)) ph7(F);
    if (IN(7) && IN(9)) xcd_barrier(bar); else __syncthreads();
    if (IN(9)) { ph9(F); if (PROBE_PHASE == 9) ph9(F); }
    SEAM(9);
    if (IN(10)) { ph10(F); if (PROBE_PHASE == 10) ph10(F); }
    SEAM(10);
    if (IN(11)) { ph11(F); if (PROBE_PHASE == 11) ph11(F); }
#undef IN
#undef SEAM
}

extern "C" void kernel_launch(void* const* d_in, const int* in_sizes, int n_in, void* d_out, int out_size, void* d_ws, size_t ws_size, hipStream_t stream) {
    static int grid = 0;
    if (grid == 0) {
        if (n_in != 27 || out_size != T_ * D_ || ws_size < WS_END) { fprintf(stderr, "kernel_launch: unexpected shapes (n_in %d out %d ws %zu need %zu)\n", n_in, out_size, ws_size, (size_t)WS_END); grid = -1; return; }
        int dev = 0, cus = 0, per_cu = 0;
        if (hipGetDevice(&dev) != hipSuccess || hipDeviceGetAttribute(&cus, hipDeviceAttributeMultiprocessorCount, dev) != hipSuccess) { grid = -1; return; }
        if (hipFuncSetAttribute((const void*)hybrid_fwd, hipFuncAttributeMaxDynamicSharedMemorySize, LDS_BYTES) != hipSuccess) { fprintf(stderr, "kernel_launch: hipFuncSetAttribute failed\n"); grid = -1; return; }
        if (hipOccupancyMaxActiveBlocksPerMultiprocessor(&per_cu, (const void*)hybrid_fwd, NTHR, LDS_BYTES) != hipSuccess || per_cu < 1) { fprintf(stderr, "kernel_launch: occupancy query says %d\n", per_cu); (void)hipGetLastError(); }
        grid = cus;
        if (grid != 256) { fprintf(stderr, "kernel_launch: built for a 256-CU device, found %d CUs\n", cus); grid = -1; return; }
    }
    if (grid < 0) return;
    hipMemsetAsync((char*)d_ws + WS_CTL, 0, CTL_BYTES, stream);
    Params p{};
    for (int i = 0; i < 27; ++i) p.in[i] = (const float*)d_in[i];
    p.out = (float*)d_out; p.ws = (unsigned char*)d_ws;
#if MK_N_LAUNCHES == 1
    p.ph_lo = 0; p.ph_hi = N_PHASES;
    hipLaunchKernelGGL(hybrid_fwd, dim3(grid), dim3(NTHR), LDS_BYTES, stream, p);
#else
    for (int k = 0; k < 12; ++k) { p.ph_lo = k; p.ph_hi = k + 1; hipLaunchKernelGGL(hybrid_fwd, dim3(grid), dim3(NTHR), LDS_BYTES, stream, p); }
#endif
}
```

```cpp
#include <hip/hip_runtime.h>
#include <cstdio>
#include <cstdint>

#ifndef MK_N_LAUNCHES
#define MK_N_LAUNCHES 1
#endif

#ifndef PROBE_PHASE
#define PROBE_PHASE -1
#endif
#define LAS __attribute__((address_space(3)))
typedef unsigned short bf16_t;
typedef short bf16x8 __attribute__((ext_vector_type(8)));
typedef float f32x4 __attribute__((ext_vector_type(4)));
typedef float f32x16 __attribute__((ext_vector_type(16)));
typedef unsigned u32x4 __attribute__((ext_vector_type(4)));
typedef unsigned u32x2 __attribute__((ext_vector_type(2)));
typedef int i32x8 __attribute__((ext_vector_type(8)));
typedef float f32x2 __attribute__((ext_vector_type(2)));
typedef int i32x4 __attribute__((ext_vector_type(4)));
constexpr float W8_SCALE = 32.f, W8_INV = 1.f / 32.f;
__device__ __forceinline__ unsigned pk4_fp8(float a, float b, float c, float d) { int v = __builtin_amdgcn_cvt_pk_fp8_f32(a, b, 0, false); v = __builtin_amdgcn_cvt_pk_fp8_f32(c, d, v, true); return (unsigned)v; }

constexpr int T_ = 32768, D_ = 1024, L_ = 4096, NB_ = 8;
constexpr int NTHR = 512;
constexpr int NEXP = 32, TOPK = 4;
constexpr int MAXROWS = T_ * TOPK + NEXP * 256;
constexpr int IN_TOTAL = 8224;

constexpr int REG_BYTES = 150528, MISC_OFF = REG_BYTES, MISC_BYTES = 8192, LDS_BYTES = REG_BYTES + MISC_BYTES;
constexpr int CVT_FIRST = 48;
constexpr int MW_Q = 8, MW_CNT = 16, MW_BASE = 48, MW_ROWB = 80, MW_RT = 113, MW_SEL = 256, MW_TILE = 1792;

constexpr size_t MiB = 1048576;
constexpr size_t WS_CTL = 0, CTL_BYTES = 65536;
constexpr size_t WS_EIDX = 1 * MiB, WS_POSE = WS_EIDX + MiB / 2, WS_WGT = 2 * MiB, WS_DEST = WS_WGT + MiB / 2, WS_SUMSQ = 3 * MiB;
constexpr size_t WS_R1 = 5 * MiB;
constexpr size_t WS_QT = WS_R1, WS_KT = WS_R1 + 64 * MiB, WS_KE = WS_R1 + 128 * MiB;
constexpr size_t WS_A = 197 * MiB, WS_B = WS_A + 272 * MiB, WS_C = WS_B + 272 * MiB, WS_END = WS_C + 256 * MiB;
constexpr size_t WS_PHY = WS_A, WS_PR = WS_A + 192 * MiB, WS_WBIN = WS_A + 256 * MiB;
constexpr size_t WS_OF = WS_C, WS_OB = WS_C + 192 * MiB, WS_Y = WS_A + 128 * MiB;
constexpr size_t WS_HNS = WS_A, WS_OUTP = WS_A;
constexpr size_t WS_PQKV = WS_B, WS_PG = WS_B, WS_ALOW = WS_B + 256 * MiB,
     WS_WBBG = WS_B + 260 * MiB, WS_WBBH = WS_B + 262 * MiB, WS_WBOUT = WS_B + 264 * MiB;
constexpr size_t WS_HRAW = WS_C + 128 * MiB  , WS_DEC = WS_B + 266 * MiB, WS_XN8 = WS_B + 224 * MiB, WS_WBIN8 = WS_WBIN + 12 * MiB, WS_LIST = WS_B + 64 * MiB;
constexpr size_t WS_WBGU = WS_B + 128 * MiB, WS_WBDN = WS_B + 192 * MiB;
constexpr size_t WS_OGLA = WS_R1, WS_OHY = WS_R1 + 64 * MiB, WS_ACT = WS_R1;
constexpr size_t WS_Z = WS_C, WS_M1 = WS_C, WS_HN = WS_C, WS_X0C = WS_C + 64 * MiB, WS_MERGED = WS_X0C, WS_RT = WS_C + 128 * MiB, WS_XN = WS_C + 192 * MiB, WS_H = WS_RT;
constexpr size_t WS_ZT = WS_Z, WS_YT = WS_Y, WS_RN = WS_CTL + 65536;
constexpr int CW_BAR = 0;
constexpr int CW_GCOUNT = 4096;
constexpr int CW_CONVQ = 4160;
constexpr int CW_CVTQ = 4352;

__device__ __forceinline__ float bf2f(bf16_t b) { return __uint_as_float(((unsigned)b) << 16); }
__device__ __forceinline__ float bflo(unsigned w) { return __uint_as_float(w << 16); }
__device__ __forceinline__ float bfhi(unsigned w) { return __uint_as_float(w & 0xffff0000u); }
typedef __bf16 bf16v2_t __attribute__((ext_vector_type(2)));
__device__ __forceinline__ bf16_t f2bf(float f) { return __builtin_bit_cast(unsigned short, (__bf16)f); }
__device__ __forceinline__ unsigned pk2(float lo, float hi) { bf16v2_t v; v.x = (__bf16)lo; v.y = (__bf16)hi; return __builtin_bit_cast(unsigned, v); }
__device__ __forceinline__ unsigned pkc(float lo, float hi) { bf16v2_t v; v.x = (__bf16)lo; v.y = (__bf16)hi; return __builtin_bit_cast(unsigned, v); }
__device__ __forceinline__ bf16x8 pack8(const f32x16& x, int s8) { u32x4 p; p.x = pkc(x[s8], x[s8 + 1]); p.y = pkc(x[s8 + 2], x[s8 + 3]); p.z = pkc(x[s8 + 4], x[s8 + 5]); p.w = pkc(x[s8 + 6], x[s8 + 7]); return __builtin_bit_cast(bf16x8, p); }
__device__ __forceinline__ int swap23(int k) { return 8 * ((k >> 2) & 1) + 4 * (k >> 3) + (k & 3); }
__device__ __forceinline__ float sigmoidf_(float x) { return __builtin_amdgcn_rcpf(1.f + __builtin_amdgcn_exp2f(-1.4426950408889634f * x)); }
__device__ __forceinline__ float wave_sum(float v) {
#pragma unroll
    for (int o = 32; o > 0; o >>= 1) v += __shfl_xor(v, o);
    return v;
}

namespace pg8 {
#define PG8_LAS __attribute__((address_space(3)))
constexpr int BM = 256, BK = 64, HALF = 128, HTB = HALF * BK * 2, STAGE_BYTES = 8 * HTB, NXCD = 8, WGM = 8;
__host__ __device__ __forceinline__ int lds_byte(int r, int c) { const int st = (r >> 4) * 2 + (c >> 5), rr = r & 15, cc = c & 31, ob = rr * 64 + cc * 2; return st * 1024 + (ob ^ (((ob >> 9) & 1) << 5)); }
__host__ __device__ __forceinline__ void stage_rc(int b, int& R, int& C) { const int st = b / 1024, sb = b % 1024, swz = sb ^ (((sb >> 9) & 1) << 5); R = (st >> 1) * 16 + swz / 64; C = (st & 1) * 32 + (swz % 64) / 2; }
__host__ __device__ __forceinline__ int perm32(int rho) { const int n = rho >> 4, i = rho & 15; return 8 * (i >> 2) + 4 * n + (i & 3); }

struct Unit { int pm, pn, e; };

__device__ __forceinline__ void tile_of(int wgid, int nM, int nN, int& pm, int& pn) {
    const int nwg = nM * nN;
    { const int q = nwg / NXCD, r = nwg % NXCD, xcd = wgid % NXCD, off = wgid / NXCD; wgid = (xcd < r ? xcd * (q + 1) : r * (q + 1) + (xcd - r) * q) + off; }
    const int nig = WGM * nN, gid = wgid / nig, fm = gid * WGM, gsz = (nM - fm) < WGM ? (nM - fm) : WGM;
    pm = fm + ((wgid % nig) % gsz); pn = (wgid % nig) / gsz;
}
struct StaticOrder {
    static constexpr bool GATHER = false;
    const bf16_t* A; const bf16_t* Bt; int K, pitch, nM, nN, nwg, G, c;
    __device__ void init(const void* A_, const void* Bt_, int M, int N, int K_, int G_, int c_, int esz = 2) { A = (const bf16_t*)A_; Bt = (const bf16_t*)Bt_; K = K_; pitch = esz * K_; nM = M / BM; nN = N / BM; nwg = nM * nN; G = G_; c = c_; }
    __device__ __forceinline__ bool next(int i, Unit& u) const {
        const long Lq = (long)i * G + c; if (Lq >= nwg) return false;
        tile_of((int)Lq, nM, nN, u.pm, u.pn); u.e = 0; return true;
    }
    __device__ __forceinline__ const void* a_base() const { return A; }
    __device__ __forceinline__ const void* b_base() const { return Bt; }
    __device__ __forceinline__ unsigned a_off(const Unit& u) const { return (unsigned)(u.pm * BM) * (unsigned)pitch; }
    __device__ __forceinline__ unsigned b_off(const Unit& u) const { return (unsigned)(u.pn * BM) * (unsigned)pitch; }
};
struct DualOrder {
    static constexpr bool GATHER = false;
    const bf16_t* A; const bf16_t* Bt; unsigned a2, b2; int K, pitch, nM, nN, nwg, G, c;
    __device__ void init(const bf16_t* A_, const bf16_t* Bt_, unsigned a2_, unsigned b2_, int M, int N, int K_, int G_, int c_) { A = A_; Bt = Bt_; a2 = a2_; b2 = b2_; K = K_; pitch = 2 * K_; nM = M / BM; nN = N / BM; nwg = nM * nN; G = G_; c = c_; }
    __device__ __forceinline__ bool next(int i, Unit& u) const {
        const long Lq = (long)(i >> 1) * G + c; if (Lq >= nwg) return false;
        tile_of((int)Lq, nM, nN, u.pm, u.pn); u.e = i & 1; return true;
    }
    __device__ __forceinline__ const void* a_base() const { return A; }
    __device__ __forceinline__ const void* b_base() const { return Bt; }
    __device__ __forceinline__ unsigned a_off(const Unit& u) const { return (unsigned)(u.pm * BM) * (unsigned)pitch + (u.e ? a2 : 0u); }
    __device__ __forceinline__ unsigned b_off(const Unit& u) const { return (unsigned)(u.pn * BM) * (unsigned)pitch + (u.e ? b2 : 0u); }
};
struct GroupedOrder {
    static constexpr bool GATHER = false;
    const void* A; const void* Bt; const LAS unsigned char* tile_e; int K, pitch, N, nM, nN, nwg, G, c;
    __device__ void init(const void* A_, const void* Bt_, const LAS unsigned char* te, int RT, int N_, int K_, int esz, int G_, int c_) { A = A_; Bt = Bt_; tile_e = te; K = K_; pitch = esz * K_; N = N_; nM = RT; nN = N_ / BM; nwg = nM * nN; G = G_; c = c_; }
    __device__ __forceinline__ bool next(int i, Unit& u) const {
        const long Lq = (long)i * G + c; if (Lq >= nwg) return false;
        tile_of((int)Lq, nM, nN, u.pm, u.pn); u.e = tile_e[u.pm]; return true;
    }
    __device__ __forceinline__ const void* a_base() const { return A; }
    __device__ __forceinline__ const void* b_base() const { return Bt; }
    __device__ __forceinline__ unsigned a_off(const Unit& u) const { return (unsigned)(u.pm * BM) * (unsigned)pitch; }
    __device__ __forceinline__ unsigned b_off(const Unit& u) const { return (unsigned)(u.e * N + u.pn * BM) * (unsigned)pitch; }
};

struct GatherOrder {
    static constexpr bool GATHER = true;
    const void* A; const void* Bt; const LAS unsigned char* tile_e; const LAS unsigned char* slot; const LAS int* tab; int K, pitch, N, nM, nN, nwg, G, c;
    __device__ void init(const void* A_, const void* Bt_, const LAS unsigned char* te, const LAS unsigned char* sl, const LAS int* tb, int RT, int N_, int K_, int esz, int G_, int c_) { A = A_; Bt = Bt_; tile_e = te; slot = sl; tab = tb; K = K_; pitch = esz * K_; N = N_; nM = RT; nN = N_ / BM; nwg = nM * nN; G = G_; c = c_; }
    __device__ __forceinline__ bool next(int i, Unit& u) const {
        const long Lq = (long)i * G + c; if (Lq >= nwg) return false;
        tile_of((int)Lq, nM, nN, u.pm, u.pn); u.e = tile_e[u.pm]; return true;
    }
    __device__ __forceinline__ const void* a_base() const { return A; }
    __device__ __forceinline__ const void* b_base() const { return Bt; }
    __device__ __forceinline__ unsigned a_off(const Unit&) const { return 0u; }
    __device__ __forceinline__ unsigned b_off(const Unit& u) const { return (unsigned)(u.e * N + u.pn * BM) * (unsigned)pitch; }
    __device__ __forceinline__ int row_of(const Unit& u, int r) const { return tab[(int)slot[u.pm] * 256 + r]; }
};

__device__ __forceinline__ unsigned cvt_pk_bf16(float lo, float hi) { unsigned r; asm volatile("v_cvt_pk_bf16_f32 %0, %1, %2" : "=v"(r) : "v"(lo), "v"(hi)); return r; }

template <class E, class = void> struct EpiTrans { static constexpr bool value = false; };
template <class E> struct EpiTrans<E, decltype((void)E::TRANS)> { static constexpr bool value = E::TRANS; };
template <class Epi, class Sched, bool F8 = false>
__device__ __forceinline__ void gemm_phase(PG8_LAS unsigned char* lds, const Sched& S, const Epi& E) {
    constexpr bool TR = EpiTrans<Epi>::value;
    static_assert(!(TR && (F8 || Sched::GATHER)), "transposed output: bf16 dense only");
    int lane; asm volatile("v_mbcnt_lo_u32_b32 %0, -1, 0\n\tv_mbcnt_hi_u32_b32 %0, -1, %0" : "=v"(lane));
    const int wid = __builtin_amdgcn_readfirstlane(threadIdx.x >> 6), tid = wid * 64 + lane, wr = wid >> 2, wc = wid & 3, fr = lane & 15, fq = lane >> 4;
    const int pitch = S.pitch, nt = pitch / 128;
    unsigned voffA[2][2], voffN[2][2], voffB[2]; int rowA[2], colA[2];
#pragma unroll
    for (int i = 0; i < 2; ++i) { int R, C; stage_rc(tid * 16 + i * 8192, R, C); const int Rp = Epi::PERM ? ((R & ~31) + perm32(R & 31)) : R, Rb = TR ? R : Rp, Ra = TR ? Rp : R;
        rowA[i] = R; colA[i] = C; voffB[i] = (unsigned)(Rb * pitch + C * 2);
#pragma unroll
        for (int hf = 0; hf < 2; ++hf) { voffA[hf][i] = (unsigned)((Ra + HALF * hf) * pitch + C * 2); voffN[hf][i] = voffA[hf][i]; } }
    const unsigned kstep = 128u, hstep = (unsigned)(HALF * pitch);
    const unsigned ldsw = (unsigned)wid * 1024u;
    const int aoff = lds_byte(wr * 64 + fr, fq * 8), boff = lds_byte(wc * 32 + fr, fq * 8);
    const __amdgpu_buffer_rsrc_t rA = __builtin_amdgcn_make_buffer_rsrc((void*)S.a_base(), 0, 0x7FFFFFFF, 0x00020000), rB = __builtin_amdgcn_make_buffer_rsrc((void*)S.b_base(), 0, 0x7FFFFFFF, 0x00020000);
#define PG8_SA(b, h) (((b) * 2 + (h)) * HTB)
#define PG8_SB(b, h) ((4 + (b) * 2 + (h)) * HTB)
#define PG8_SBR(b, h) (((b) * 2 + (h)) * HTB)
    const PG8_LAS unsigned char* ldsB = lds + 4 * HTB + boff; asm volatile("" : "+v"(ldsB));
#define PG8_STAGE(bufoff, rsrc, soff, voff) do { _Pragma("unroll") for (int _i = 0; _i < 2; ++_i) \
        __builtin_amdgcn_raw_ptr_buffer_load_lds(rsrc, (PG8_LAS void*)(lds + (bufoff) + ldsw + _i * 8192), 16, (voff)[_i], (int)(soff), 0, 0); } while (0)
#define PG8_GATHER_OFFS(dst, unit) do { if constexpr (Sched::GATHER) { _Pragma("unroll") for (int _h = 0; _h < 2; ++_h) _Pragma("unroll") for (int _i = 0; _i < 2; ++_i) \
        dst[_h][_i] = (unsigned)(S.row_of(unit, rowA[_i] + HALF * _h) * pitch + colA[_i] * 2); } } while (0)
#define PG8_LDA(dst, b, h) do { _Pragma("unroll") for (int m = 0; m < 4; ++m) { if constexpr (F8) { const i32x4 _lo = *(const PG8_LAS i32x4*)(lds + PG8_SA(b, h) + aoff + m * 2048), _hi = *(const PG8_LAS i32x4*)(lds + PG8_SA(b, h) + aoff + m * 2048 + 1024); dst##8[m] = __builtin_shufflevector(_lo, _hi, 0, 1, 2, 3, 4, 5, 6, 7); } \
        else { _Pragma("unroll") for (int k = 0; k < 2; ++k) dst[m][k] = *(const PG8_LAS bf16x8*)(lds + PG8_SA(b, h) + aoff + m * 2048 + k * 1024); } } } while (0)
#define PG8_LDB(dst, b, h) do { _Pragma("unroll") for (int n = 0; n < 2; ++n) { if constexpr (F8) { const i32x4 _lo = *(const PG8_LAS i32x4*)(ldsB + PG8_SBR(b, h) + n * 2048), _hi = *(const PG8_LAS i32x4*)(ldsB + PG8_SBR(b, h) + n * 2048 + 1024); dst##8[n] = __builtin_shufflevector(_lo, _hi, 0, 1, 2, 3, 4, 5, 6, 7); } \
        else { _Pragma("unroll") for (int k = 0; k < 2; ++k) dst[n][k] = *(const PG8_LAS bf16x8*)(ldsB + PG8_SBR(b, h) + n * 2048 + k * 1024); } } } while (0)
#define PG8_MMA(ai, bj, At, Bt) do { __builtin_amdgcn_s_setprio(1); _Pragma("unroll") for (int m = 0; m < 4; ++m) _Pragma("unroll") for (int n = 0; n < 2; ++n) { if constexpr (F8) { \
            asm volatile("v_mfma_scale_f32_16x16x128_f8f6f4 %0, %1, %2, %0, %3, %3 op_sel_hi:[0,0,0]" : "+v"(acc[ai][bj][m][n]) : "v"(Bt##8[n]), "v"(At##8[m]), "v"(sc8)); } \
        else { _Pragma("unroll") for (int k = 0; k < 2; ++k) { if constexpr (TR) acc[ai][bj][m][n] = __builtin_amdgcn_mfma_f32_16x16x32_bf16(At[m][k], Bt[n][k], acc[ai][bj][m][n], 0, 0, 0); \
            else acc[ai][bj][m][n] = __builtin_amdgcn_mfma_f32_16x16x32_bf16(Bt[n][k], At[m][k], acc[ai][bj][m][n], 0, 0, 0); } } } \
        __builtin_amdgcn_s_setprio(0); } while (0)
#define PG8_WAIT_V(n) asm volatile("s_waitcnt vmcnt(" #n ")" ::: "memory")
#define PG8_WAIT_V8R() do { if (relax_now) asm volatile("s_waitcnt vmcnt(%0)" :: "n"(8 + Epi::NSTORES) : "memory"); else asm volatile("s_waitcnt vmcnt(8)" ::: "memory"); } while (0)
#define PG8_WAIT_L(n) asm volatile("s_waitcnt lgkmcnt(" #n ")" ::: "memory")
#define PG8_BAR __builtin_amdgcn_s_barrier()
#define PG8_SCHED __builtin_amdgcn_sched_barrier(0)
    Unit cur, nxt; int ui = 0; bool relax = false;
    if (!S.next(0, cur)) return;
    f32x4 acc[2][2][4][2];
#pragma unroll
    for (int a = 0; a < 2; ++a)
#pragma unroll
        for (int b = 0; b < 2; ++b)
#pragma unroll
            for (int m = 0; m < 4; ++m)
#pragma unroll
                for (int n = 0; n < 2; ++n) acc[a][b][m][n] = (f32x4){0.f, 0.f, 0.f, 0.f};
    bf16x8 At[4][2], B0[2][2], B1[2][2]; i32x8 At8[4], B08[2], B18[2];
    const int sc8 = 0x7F7F7F7F;
    unsigned cA = S.a_off(cur), cB = S.b_off(cur);
    PG8_GATHER_OFFS(voffA, cur);
    PG8_STAGE(PG8_SB(0, 0), rB, cB, voffB); PG8_STAGE(PG8_SB(0, 1), rB, cB + hstep, voffB); PG8_STAGE(PG8_SA(0, 0), rA, cA, voffA[0]); PG8_STAGE(PG8_SA(0, 1), rA, cA, voffA[1]);
    if (wr == 1) PG8_BAR;
    PG8_WAIT_V(2); PG8_BAR;
    PG8_STAGE(PG8_SB(1, 0), rB, cB + kstep, voffB); PG8_STAGE(PG8_SA(1, 0), rA, cA + kstep, voffA[0]); PG8_STAGE(PG8_SB(1, 1), rB, cB + hstep + kstep, voffB);
    PG8_WAIT_V(6); PG8_BAR;
    for (;;) {
        const bool has_next = S.next(ui + 1, nxt);
        const unsigned nA = has_next ? S.a_off(nxt) : cA, nB = has_next ? S.b_off(nxt) : cB;
        if constexpr (Sched::GATHER) { if (has_next) { PG8_GATHER_OFFS(voffN, nxt); } else {
#pragma unroll
            for (int hf = 0; hf < 2; ++hf) { voffN[hf][0] = voffA[hf][0]; voffN[hf][1] = voffA[hf][1]; } } }
        for (int t = 0; t < nt; t += 2) {
            const bool last = (t == nt - 2), relax_now = relax && (t == 0);
            unsigned v2[2][2];
#pragma unroll
            for (int hf = 0; hf < 2; ++hf) { if constexpr (Sched::GATHER) { v2[hf][0] = last ? voffN[hf][0] : voffA[hf][0]; v2[hf][1] = last ? voffN[hf][1] : voffA[hf][1]; } else { v2[hf][0] = voffA[hf][0]; v2[hf][1] = voffA[hf][1]; } }
            const unsigned a1 = cA + (unsigned)(t + 1) * kstep;
            const unsigned a2 = last ? nA : cA + (unsigned)(t + 2) * kstep, b2 = last ? nB : cB + (unsigned)(t + 2) * kstep;
            const unsigned a3 = a2 + kstep, b3 = b2 + kstep;
            PG8_LDB(B0, 0, 0); PG8_LDB(B1, 0, 1); PG8_SCHED; PG8_LDA(At, 0, 0); PG8_STAGE(PG8_SA(1, 1), rA, a1, voffA[1]);
            PG8_WAIT_V8R(); PG8_WAIT_L(0); PG8_BAR; PG8_MMA(0, 0, At, B0); PG8_MMA(0, 1, At, B1); PG8_BAR; PG8_SCHED;
            PG8_LDA(At, 0, 1); PG8_STAGE(PG8_SB(0, 0), rB, b2, voffB); PG8_STAGE(PG8_SB(0, 1), rB, b2 + hstep, voffB); PG8_STAGE(PG8_SA(0, 0), rA, a2, v2[0]);
            PG8_WAIT_V8R(); PG8_WAIT_L(0); PG8_BAR; PG8_MMA(1, 0, At, B0); PG8_MMA(1, 1, At, B1); PG8_BAR; PG8_SCHED;
            PG8_LDB(B0, 1, 0); PG8_LDB(B1, 1, 1); PG8_SCHED; PG8_LDA(At, 1, 0); PG8_STAGE(PG8_SA(0, 1), rA, a2, v2[1]);
            PG8_WAIT_V(8); PG8_WAIT_L(0); PG8_BAR; PG8_MMA(0, 0, At, B0); PG8_MMA(0, 1, At, B1); PG8_BAR; PG8_SCHED;
            PG8_LDA(At, 1, 1); PG8_STAGE(PG8_SB(1, 0), rB, b3, voffB); PG8_STAGE(PG8_SB(1, 1), rB, b3 + hstep, voffB); PG8_STAGE(PG8_SA(1, 0), rA, a3, v2[0]);
            PG8_WAIT_V(8); PG8_WAIT_L(0); PG8_BAR; PG8_MMA(1, 0, At, B0); PG8_MMA(1, 1, At, B1); PG8_BAR; PG8_SCHED;
        }
        if (wr == 0) PG8_BAR;
        if constexpr (F8) asm volatile("s_nop 15\n\ts_nop 3" ::: "memory");
        { int l2; asm volatile("v_mbcnt_lo_u32_b32 %0, -1, 0\n\tv_mbcnt_hi_u32_b32 %0, -1, %0" : "=v"(l2)); E(acc, cur, wr, wc, l2 & 15, l2 >> 4); if (PROBE_PHASE == 100) E(acc, cur, wr, wc, l2 & 15, l2 >> 4); }
        if (!has_next) break;
        if (!(Epi::DUAL && cur.e == 0)) {
#pragma unroll
        for (int a = 0; a < 2; ++a)
#pragma unroll
            for (int b = 0; b < 2; ++b)
#pragma unroll
                for (int m = 0; m < 4; ++m)
#pragma unroll
                    for (int n = 0; n < 2; ++n) acc[a][b][m][n] = (f32x4){0.f, 0.f, 0.f, 0.f};
        }
        relax = Epi::DUAL ? (cur.e == 1) : true;
        cur = nxt; cA = nA; cB = nB; ++ui;
        if constexpr (Sched::GATHER) {
#pragma unroll
            for (int hf = 0; hf < 2; ++hf) { voffA[hf][0] = voffN[hf][0]; voffA[hf][1] = voffN[hf][1]; } }
        if (wr == 1) PG8_BAR;
    }
    PG8_WAIT_V(0);
    PG8_BAR;
#undef PG8_SA
#undef PG8_SB
#undef PG8_SBR
#undef PG8_STAGE
#undef PG8_GATHER_OFFS
#undef PG8_LDA
#undef PG8_LDB
#undef PG8_MMA
#undef PG8_WAIT_V
#undef PG8_WAIT_V8R
#undef PG8_WAIT_L
#undef PG8_BAR
#undef PG8_SCHED
}

__device__ __forceinline__ void store16_pair(unsigned char* px, unsigned char* py, u32x2 a, u32x2 b, int fq) {
    const auto r0 = __builtin_amdgcn_permlane16_swap(a.x, b.x, false, false);
    const auto r1 = __builtin_amdgcn_permlane16_swap(a.y, b.y, false, false);
    u32x4 w; w.x = r0[0]; w.y = r1[0]; w.z = r0[1]; w.w = r1[1];
    *(u32x4*)((fq & 1) ? (py - 8) : px) = w;
}
struct EpiInProj {
    static constexpr int NSTORES = 16;
    static constexpr bool DUAL = false;
    static constexpr bool PERM = true;
    bf16_t *qkv, *r, *hy, *g; int pn_off;
    __device__ __forceinline__ void operator()(const f32x4 (&acc)[2][2][4][2], const Unit& u0, int wr, int wc, int fr, int fq) const {
        Unit u = u0; u.pn += pn_off;
        bf16_t* base; int ldc, ct;
        if (u.pn < 8) { base = qkv; ldc = 2048; ct = u.pn; } else if (u.pn < 12) { base = r; ldc = 1024; ct = u.pn - 8; }
        else if (u.pn < 16) { base = g; ldc = 1024; ct = u.pn - 12; } else { base = hy; ldc = 2048; ct = u.pn - 16; }
        const float sc = (u.pn < 2) ? 0.08838834764831845f : 1.f;
        const int row0 = u.pm * BM + wr * 64 + fr, col0 = ct * BM + wc * 32 + 8 * fq;
#pragma unroll
        for (int ai = 0; ai < 2; ++ai)
#pragma unroll
            for (int m = 0; m < 4; ++m) { bf16_t* rowp = base + (size_t)(row0 + ai * HALF + m * 16) * ldc + col0;
#pragma unroll
                for (int bj = 0; bj < 2; ++bj) { const f32x4 v0 = acc[ai][bj][m][0] * sc, v1 = acc[ai][bj][m][1] * sc; u32x4 w;
                    w.x = cvt_pk_bf16(v0[0], v0[1]); w.y = cvt_pk_bf16(v0[2], v0[3]); w.z = cvt_pk_bf16(v1[0], v1[1]); w.w = cvt_pk_bf16(v1[2], v1[3]);
                    *(u32x4*)(rowp + bj * HALF) = w; } }
    }
};
struct EpiHyT {
    static constexpr int NSTORES = 16;
    static constexpr bool DUAL = false, PERM = true, TRANS = true;
    bf16_t* XT;
    __device__ __forceinline__ void operator()(const f32x4 (&acc)[2][2][4][2], const Unit& u, int wr, int wc, int fr, int fq) const {
        const int row0 = u.pm * BM + wr * 64 + 8 * fq, col0 = u.pn * BM + wc * 32 + fr;
#pragma unroll
        for (int bj = 0; bj < 2; ++bj)
#pragma unroll
            for (int n = 0; n < 2; ++n) { bf16_t* colp = XT + (size_t)(col0 + bj * HALF + n * 16) * T_ + row0;
#pragma unroll
                for (int ai = 0; ai < 2; ++ai)
#pragma unroll
                    for (int mp = 0; mp < 2; ++mp) { const f32x4 v0 = acc[ai][bj][2 * mp][n], v1 = acc[ai][bj][2 * mp + 1][n]; u32x4 w;
                        w.x = cvt_pk_bf16(v0[0], v0[1]); w.y = cvt_pk_bf16(v0[2], v0[3]); w.z = cvt_pk_bf16(v1[0], v1[1]); w.w = cvt_pk_bf16(v1[2], v1[3]);
                        *(u32x4*)(colp + ai * HALF + mp * 32) = w; } }
    }
};
struct EpiGates8 {
    static constexpr int NSTORES = 8;
    static constexpr bool CONT64 = false;
    static constexpr bool PERM = true, DUAL = false;
    unsigned char* G8;
    __device__ __forceinline__ void operator()(const f32x4 (&acc)[2][2][4][2], const Unit& u, int wr, int wc, int fr, int fq) const {
        const int row0 = u.pm * BM + wr * 64 + fr, col0 = u.pn * BM + wc * 32 + 8 * fq;
#pragma unroll
        for (int ai = 0; ai < 2; ++ai)
#pragma unroll
            for (int mp = 0; mp < 2; ++mp) { unsigned char* rowx = G8 + (size_t)(row0 + ai * HALF + (2 * mp) * 16) * 2048 + col0; unsigned char* rowy = rowx + 16 * 2048;
#pragma unroll
                for (int bj = 0; bj < 2; ++bj) { u32x2 a, b;
                    { const f32x4 v0 = acc[ai][bj][2 * mp][0] * W8_INV, v1 = acc[ai][bj][2 * mp][1] * W8_INV; a.x = pk4_fp8(v0[0], v0[1], v0[2], v0[3]); a.y = pk4_fp8(v1[0], v1[1], v1[2], v1[3]); }
                    { const f32x4 v0 = acc[ai][bj][2 * mp + 1][0] * W8_INV, v1 = acc[ai][bj][2 * mp + 1][1] * W8_INV; b.x = pk4_fp8(v0[0], v0[1], v0[2], v0[3]); b.y = pk4_fp8(v1[0], v1[1], v1[2], v1[3]); }
                    store16_pair(rowx + bj * HALF, rowy + bj * HALF, a, b, fq); } }
    }
};
#define EXPN(x) __builtin_amdgcn_exp2f(-1.4426950408889634f * (x))
struct EpiMerge {
    static constexpr int NSTORES = 16;
    static constexpr bool PERM = true, DUAL = true;
    const unsigned char* g; bf16_t* O;
    __device__ __forceinline__ void operator()(f32x4 (&acc)[2][2][4][2], const Unit& u, int wr, int wc, int fr, int fq) const {
        const int row0 = u.pm * BM + wr * 64 + fr, col0 = u.pn * BM + wc * 32 + 8 * fq;
        u32x2 g2w[2][4][2], g1w[2][4][2];
#pragma unroll
        for (int ai = 0; ai < 2; ++ai)
#pragma unroll
            for (int m = 0; m < 4; ++m) { const size_t row = (size_t)(row0 + ai * HALF + m * 16);
#pragma unroll
                for (int bj = 0; bj < 2; ++bj) { const int col = col0 + bj * HALF; g2w[ai][m][bj] = *(const u32x2*)(g + row * 2048 + 1024 + col);
                    if (u.e == 0) g1w[ai][m][bj] = *(const u32x2*)(g + row * 2048 + col); } }
#pragma unroll
        for (int ai = 0; ai < 2; ++ai)
#pragma unroll
            for (int m = 0; m < 4; ++m) { const size_t row = (size_t)(row0 + ai * HALF + m * 16);
#pragma unroll
                for (int bj = 0; bj < 2; ++bj) { const int col = col0 + bj * HALF;
                    const u32x2 g2v = g2w[ai][m][bj];
                    const f32x2 a0 = __builtin_amdgcn_cvt_pk_f32_fp8((int)g2v.x, false), a1 = __builtin_amdgcn_cvt_pk_f32_fp8((int)g2v.x, true), a2 = __builtin_amdgcn_cvt_pk_f32_fp8((int)g2v.y, false), a3 = __builtin_amdgcn_cvt_pk_f32_fp8((int)g2v.y, true);
                    float e2[8] = {EXPN(a0[0]), EXPN(a0[1]), EXPN(a1[0]), EXPN(a1[1]), EXPN(a2[0]), EXPN(a2[1]), EXPN(a3[0]), EXPN(a3[1])};
                    if (u.e == 0) { const u32x2 g1v = g1w[ai][m][bj];
                        const f32x2 c0 = __builtin_amdgcn_cvt_pk_f32_fp8((int)g1v.x, false), c1 = __builtin_amdgcn_cvt_pk_f32_fp8((int)g1v.x, true), c2 = __builtin_amdgcn_cvt_pk_f32_fp8((int)g1v.y, false), c3 = __builtin_amdgcn_cvt_pk_f32_fp8((int)g1v.y, true);
                        const float e1[8] = {EXPN(c0[0]), EXPN(c0[1]), EXPN(c1[0]), EXPN(c1[1]), EXPN(c2[0]), EXPN(c2[1]), EXPN(c3[0]), EXPN(c3[1])};
#pragma unroll
                        for (int i = 0; i < 4; ++i) { acc[ai][bj][m][0][i] *= (1.f + e2[i]) * __builtin_amdgcn_rcpf(1.f + e1[i]); acc[ai][bj][m][1][i] *= (1.f + e2[4 + i]) * __builtin_amdgcn_rcpf(1.f + e1[4 + i]); } }
                    else { f32x4 v0, v1;
#pragma unroll
                        for (int i = 0; i < 4; ++i) { v0[i] = acc[ai][bj][m][0][i] * __builtin_amdgcn_rcpf(1.f + e2[i]); v1[i] = acc[ai][bj][m][1][i] * __builtin_amdgcn_rcpf(1.f + e2[4 + i]); }
                        u32x4 w; w.x = cvt_pk_bf16(v0[0], v0[1]); w.y = cvt_pk_bf16(v0[2], v0[3]); w.z = cvt_pk_bf16(v1[0], v1[1]); w.w = cvt_pk_bf16(v1[2], v1[3]);
                        *(u32x4*)(O + row * 1024 + col) = w; } } }
    }
};
#undef EXPN
struct EpiResid {
    static constexpr int NSTORES = 16;
    static constexpr bool DUAL = false;
    static constexpr bool PERM = true;
    const float* x; bf16_t* H;
    __device__ __forceinline__ void operator()(const f32x4 (&acc)[2][2][4][2], const Unit& u, int wr, int wc, int fr, int fq) const {
        const int row0 = u.pm * BM + wr * 64 + fr, col0 = u.pn * BM + wc * 32 + 8 * fq;
#pragma unroll
        for (int ai = 0; ai < 2; ++ai) {
            f32x4 xv[4][2][2];
#pragma unroll
            for (int m = 0; m < 4; ++m) { const size_t ro = (size_t)(row0 + ai * HALF + m * 16) * 1024 + col0;
#pragma unroll
                for (int bj = 0; bj < 2; ++bj) { const size_t o = ro + bj * HALF; xv[m][bj][0] = *(const f32x4*)(x + o); xv[m][bj][1] = *(const f32x4*)(x + o + 4); } }
#pragma unroll
            for (int m = 0; m < 4; ++m) { const size_t ro = (size_t)(row0 + ai * HALF + m * 16) * 1024 + col0;
#pragma unroll
                for (int bj = 0; bj < 2; ++bj) { const size_t o = ro + bj * HALF; const f32x4 v0 = acc[ai][bj][m][0] + xv[m][bj][0], v1 = acc[ai][bj][m][1] + xv[m][bj][1]; u32x4 w;
                    w.x = cvt_pk_bf16(v0[0], v0[1]); w.y = cvt_pk_bf16(v0[2], v0[3]); w.z = cvt_pk_bf16(v1[0], v1[1]); w.w = cvt_pk_bf16(v1[2], v1[3]);
                    *(u32x4*)(H + o) = w; } } }
    }
};
struct EpiGateUp {
    static constexpr int NSTORES = 4;
    static constexpr bool CONT64 = false;
    static constexpr bool DUAL = false;
    static constexpr bool PERM = true;
    const float* bgu; unsigned char* ACT;
    __device__ __forceinline__ void operator()(const f32x4 (&acc)[2][2][4][2], const Unit& u, int wr, int wc, int fr, int fq) const {
        const int row0 = u.pm * BM + wr * 64 + fr, j0 = u.pn * HALF + wc * 32 + 8 * fq;
        const float* bg = bgu + (size_t)u.e * 2048 + j0;
        const f32x4 bg0 = *(const f32x4*)(bg), bg1 = *(const f32x4*)(bg + 4), bu0 = *(const f32x4*)(bg + 1024), bu1 = *(const f32x4*)(bg + 1028);
#pragma unroll
        for (int ai = 0; ai < 2; ++ai)
#pragma unroll
            for (int mp = 0; mp < 2; ++mp) { u32x2 pc[2];
#pragma unroll
                for (int h2 = 0; h2 < 2; ++h2) { const int m = 2 * mp + h2;
                    const f32x4 gq[2] = {acc[ai][0][m][0] * W8_INV + bg0, acc[ai][0][m][1] * W8_INV + bg1}, uq[2] = {acc[ai][1][m][0] * W8_INV + bu0, acc[ai][1][m][1] * W8_INV + bu1};
                    f32x4 oq[2];
#pragma unroll
                    for (int v = 0; v < 2; ++v) { f32x4 gt, up, ex, rc;
#pragma unroll
                        for (int i = 0; i < 4; ++i) { gt[i] = fminf(gq[v][i], 7.f); up[i] = fminf(fmaxf(uq[v][i], -7.f), 7.f); }
                        const f32x4 tt = gt * (-1.702f * 1.4426950408889634f);
#pragma unroll
                        for (int i = 0; i < 4; ++i) ex[i] = __builtin_amdgcn_exp2f(tt[i]);
                        const f32x4 dn = ex + 1.f;
#pragma unroll
                        for (int i = 0; i < 4; ++i) rc[i] = __builtin_amdgcn_rcpf(dn[i]);
                        oq[v] = (gt * rc) * (up + 1.f); }
                    pc[h2].x = pk4_fp8(oq[0][0], oq[0][1], oq[0][2], oq[0][3]); pc[h2].y = pk4_fp8(oq[1][0], oq[1][1], oq[1][2], oq[1][3]); }
                unsigned char* rowx = ACT + (size_t)(row0 + ai * HALF + (2 * mp) * 16) * 1024 + j0;
                store16_pair(rowx, rowx + 16 * 1024, pc[0], pc[1], fq); }
    }
};
struct EpiDown {
    static constexpr int NSTORES = 8;
    static constexpr bool CONT64 = false;
    static constexpr bool DUAL = false;
    static constexpr bool PERM = true;
    const float* bd; unsigned char* O;
    __device__ __forceinline__ void operator()(const f32x4 (&acc)[2][2][4][2], const Unit& u, int wr, int wc, int fr, int fq) const {
        const int row0 = u.pm * BM + wr * 64 + fr, col0 = u.pn * BM + wc * 32 + 8 * fq;
        const float* bp = bd + (size_t)u.e * 1024 + col0;
#pragma unroll
        for (int bj = 0; bj < 2; ++bj) { const f32x4 b0 = *(const f32x4*)(bp + bj * HALF), b1 = *(const f32x4*)(bp + bj * HALF + 4);
#pragma unroll
            for (int ai = 0; ai < 2; ++ai)
#pragma unroll
                for (int mp = 0; mp < 2; ++mp) { unsigned char* rowx = O + (size_t)(row0 + ai * HALF + (2 * mp) * 16) * 1024 + col0 + bj * HALF; u32x2 a, b;
                    { const f32x4 v0 = acc[ai][bj][2 * mp][0] * W8_INV + b0, v1 = acc[ai][bj][2 * mp][1] * W8_INV + b1; a.x = pk4_fp8(v0[0], v0[1], v0[2], v0[3]); a.y = pk4_fp8(v1[0], v1[1], v1[2], v1[3]); }
                    { const f32x4 v0 = acc[ai][bj][2 * mp + 1][0] * W8_INV + b0, v1 = acc[ai][bj][2 * mp + 1][1] * W8_INV + b1; b.x = pk4_fp8(v0[0], v0[1], v0[2], v0[3]); b.y = pk4_fp8(v1[0], v1[1], v1[2], v1[3]); }
                    store16_pair(rowx, rowx + 16 * 1024, a, b, fq); } }
    }
};
}

#define XB_TMO      128
#define XB_XCNT(j)  (256  + 64 * (j))
#define XB_XSUB(j)  (1280 + 64 * (j))
#define XB_XGEN(j)  (2304 + 64 * (j))
#define XB_TOP      3328
#define XB_TOPGEN   3392
#define XCD_BAR_WORDS 3456
#define XB_SPIN_CAP (1u << 18)

__device__ __forceinline__ unsigned xb_ld(unsigned* p)              { return __hip_atomic_load(p, __ATOMIC_RELAXED, __HIP_MEMORY_SCOPE_AGENT); }
__device__ __forceinline__ unsigned xb_add(unsigned* p, unsigned v) { return __hip_atomic_fetch_add(p, v, __ATOMIC_RELAXED, __HIP_MEMORY_SCOPE_AGENT); }
__device__ __forceinline__ unsigned xb_xcc_id() { return (unsigned)__builtin_amdgcn_s_getreg((3 << 11) | 20) & 0xFu; }
#define XB_SPIN(cond, bar) do { unsigned _sp = 0; while (cond) { __builtin_amdgcn_s_sleep(1); \
    if ((++_sp & 255u) == 0u) { if (xb_ld(&(bar)[XB_TMO])) break; if (_sp > XB_SPIN_CAP) { atomicAdd(&(bar)[XB_TMO], 1u); break; } } } } while (0)

struct XcdBarrier { unsigned* bar; unsigned x; volatile LAS unsigned* st; };

__device__ __forceinline__ XcdBarrier xcd_barrier_post(unsigned* bar, volatile LAS unsigned* st) {
    XcdBarrier b; b.bar = bar; b.x = xb_xcc_id(); b.st = st;
    if (threadIdx.x == 0) (void)xb_add(&bar[XB_XCNT(b.x)], 1u);
    return b;
}
__device__ __forceinline__ void xcd_barrier_complete(unsigned* bar, unsigned x, unsigned& nloc, unsigned& nx) {
    const unsigned G = gridDim.x * gridDim.y * gridDim.z;
    unsigned sum, cnt, mine, sp = 0u;
    for (;;) {
        sum = 0u; cnt = 0u; mine = 0u;
#pragma unroll
        for (unsigned j = 0; j < 16; ++j) { const unsigned c = xb_ld(&bar[XB_XCNT(j)]); sum += c; cnt += (c > 0u) ? 1u : 0u; mine = (j == x) ? c : mine; }
        if (sum == G) break;
        __builtin_amdgcn_s_sleep(1);
        if ((++sp & 255u) == 0u) { if (xb_ld(&bar[XB_TMO])) break; if (sp > XB_SPIN_CAP) { atomicAdd(&bar[XB_TMO], 1u); break; } }
    }
    nloc = mine > 0u ? mine : 1u; nx = cnt > 0u ? cnt : 1u;
}
__device__ __forceinline__ void xcd_barrier(const XcdBarrier& b) {
    asm volatile("s_waitcnt vmcnt(0)" ::: "memory");
    __syncthreads();
    if (threadIdx.x == 0) {
        unsigned* bar = b.bar;
        __builtin_amdgcn_s_waitcnt(0);
        unsigned nloc = b.st[0], nx = b.st[1];
        if (nloc == 0u) { xcd_barrier_complete(bar, b.x, nloc, nx); b.st[0] = nloc; b.st[1] = nx; }
        const unsigned old = xb_add(&bar[XB_XSUB(b.x)], 1u);
        const unsigned gen = old / nloc;
        if (old + 1u == (gen + 1u) * nloc) {
            __builtin_amdgcn_fence(__ATOMIC_RELEASE, "agent");
            asm volatile("s_waitcnt vmcnt(0)" ::: "memory");
            const unsigned og = xb_add(&bar[XB_TOP], 1u);
            const unsigned tg = og / nx;
            if (og + 1u == (tg + 1u) * nx) xb_add(&bar[XB_TOPGEN], 1u);
            else XB_SPIN(xb_ld(&bar[XB_TOPGEN]) == tg, bar);
            __builtin_amdgcn_fence(__ATOMIC_ACQUIRE, "agent");
            xb_add(&bar[XB_XGEN(b.x)], 1u);
            asm volatile("s_waitcnt vmcnt(0)" ::: "memory");
        } else {
            XB_SPIN(xb_ld(&bar[XB_XGEN(b.x)]) == gen, bar);
            __builtin_amdgcn_fence(__ATOMIC_ACQUIRE, "agent");
            asm volatile("s_waitcnt vmcnt(0)" ::: "memory");
        }
    }
    __syncthreads();
}

struct Params { const float* in[27]; float* out; unsigned char* ws; int ph_lo, ph_hi; };
struct Frame {
    LAS unsigned char* lds; LAS unsigned* misc; int tid, lane, wave, bid, G;
    const float* const* in; float* out; unsigned char* ws; unsigned* ctl;
};
enum { I_X = 0, I_N1W, I_WIN, I_GW2, I_GB, I_GNW, I_CW, I_CB, I_FREQ, I_W1, I_B1, I_W2, I_B2, I_W3, I_DECAY, I_HBIAS, I_WBG, I_WBH, I_WOUT, I_N2W, I_RW, I_RB, I_WGU, I_BGU, I_WDN, I_BDN, I_NFW };

constexpr int CVT_SMALL = 352, CVT_ALL = 3424;
constexpr int CVT_URGENT = 192;
constexpr int CVT_SPLIT = CVT_ALL - 768;
struct CvtTile { const float* src; unsigned char* dst; int ld, k0, n0, kind; bool f8; };
__device__ __forceinline__ CvtTile cvt_decode(const Frame& F, int it) {
    CvtTile t; int kt; t.f8 = it >= CVT_SMALL;
    if (it < 256) { kt = it & 15; t.n0 = (it >> 4) * 512; t.src = F.in[I_WIN]; t.ld = IN_TOTAL; t.kind = 1; t.dst = F.ws + WS_WBIN; if (t.n0 >= 6144) { t.f8 = true; t.dst = F.ws + WS_WBIN8 - (size_t)6144 * 1024; } }
    else if (it < 352) { const int j = it - 256, mat = j >> 5, rem = j & 31; kt = rem & 15; t.n0 = (rem >> 4) * 512; t.src = F.in[I_WBG + mat]; t.ld = 1024; t.kind = 0; t.dst = F.ws + WS_WBBG + (size_t)mat * 2 * MiB; }
    else if (it < 2400) { const int j = it - 352, e = j >> 6, rem = j & 63; kt = rem & 15; t.n0 = (rem >> 4) * 512; t.src = F.in[I_WGU] + (size_t)e * 1024 * 2048; t.ld = 2048; t.kind = 2; t.dst = F.ws + WS_WBGU + (size_t)e * 2048 * 1024; }
    else { const int j = it - 2400, e = j >> 5, rem = j & 31; kt = rem & 15; t.n0 = (rem >> 4) * 512; t.src = F.in[I_WDN] + (size_t)e * 1024 * 1024; t.ld = 1024; t.kind = 0; t.dst = F.ws + WS_WBDN + (size_t)e * 1024 * 1024; }
    t.k0 = kt * 64; return t;
}
__device__ __forceinline__ void cvt_request(const Frame& F, const CvtTile& t, f32x4 (&v)[16]) {
#pragma unroll
    for (int p = 0; p < 16; ++p) { const int e2 = F.tid + NTHR * p, k = e2 >> 7, nn = t.n0 + (e2 & 127) * 4; int sc = nn;
        if (t.kind == 1) sc = nn < 3072 ? nn : nn + 32;
        if (t.kind == 2) { const int pn = nn >> 8, x = nn & 255; sc = x < 128 ? 128 * pn + x : 1024 + 128 * pn + (x - 128); }
        v[p] = *(const f32x4*)(t.src + (size_t)(t.k0 + k) * t.ld + sc); }
}
__device__ __forceinline__ void cvt_to_lds(const Frame& F, const f32x4 (&v)[16]) {
    LAS float* tile = (LAS float*)F.lds;
#pragma unroll
    for (int p = 0; p < 16; ++p) { const int e2 = F.tid + NTHR * p, k = e2 >> 7, n4 = (e2 & 127) * 4; LAS float* d = tile + k * 513 + n4; d[0] = v[p][0]; d[1] = v[p][1]; d[2] = v[p][2]; d[3] = v[p][3]; }
}
__device__ __forceinline__ void cvt_write_out(const Frame& F, const CvtTile& t) {
    constexpr int RSF = 513; const LAS float* tile = (const LAS float*)F.lds;
#pragma unroll
    for (int q = 0; q < 8; ++q) { const int o = F.tid + NTHR * q, k8 = o & 7, n = o >> 3; const LAS float* t8 = tile + (8 * k8) * RSF + n;
        if (!t.f8) { u32x4 w; w.x = pk2(t8[0], t8[RSF]); w.y = pk2(t8[2 * RSF], t8[3 * RSF]); w.z = pk2(t8[4 * RSF], t8[5 * RSF]); w.w = pk2(t8[6 * RSF], t8[7 * RSF]);
            *(u32x4*)((bf16_t*)t.dst + (size_t)(t.n0 + n) * 1024 + t.k0 + 8 * k8) = w; }
        else { u32x2 w; w.x = pk4_fp8(t8[0] * W8_SCALE, t8[RSF] * W8_SCALE, t8[2 * RSF] * W8_SCALE, t8[3 * RSF] * W8_SCALE); w.y = pk4_fp8(t8[4 * RSF] * W8_SCALE, t8[5 * RSF] * W8_SCALE, t8[6 * RSF] * W8_SCALE, t8[7 * RSF] * W8_SCALE);
            *(u32x2*)(t.dst + (size_t)(t.n0 + n) * 1024 + t.k0 + 8 * k8) = w; } }
}
__device__ void cvt_weights_static(const Frame& F, int it_lo, int it_hi) {
    __syncthreads();
    for (int it = it_lo + F.bid; it < it_hi; it += F.G) {
        const CvtTile t = cvt_decode(F, it); f32x4 v[16];
        cvt_request(F, t, v);
        __syncthreads(); cvt_to_lds(F, v); __syncthreads(); cvt_write_out(F, t);
    }
    __syncthreads();
}
template <int NB>
__device__ bool cvt_batch(const Frame& F, int lo, int hi, unsigned* ctr) {
    __syncthreads();
    if (F.tid == 0) F.misc[MW_Q] = __hip_atomic_fetch_add(ctr, (unsigned)NB, __ATOMIC_RELAXED, __HIP_MEMORY_SCOPE_AGENT);
    __syncthreads();
    const int base = lo + (int)F.misc[MW_Q];
    if (base >= hi) return false;
    f32x4 v[16];
    cvt_request(F, cvt_decode(F, base), v);
#pragma unroll 1
    for (int j = 0; j < NB; ++j) { const int it = base + j; if (it >= hi) break;
        const CvtTile t = cvt_decode(F, it);
        cvt_to_lds(F, v);
        __syncthreads();
        if (j + 1 < NB && it + 1 < hi) cvt_request(F, cvt_decode(F, it + 1), v);
        cvt_write_out(F, t);
        __syncthreads(); }
    return true;
}

__device__ void p0_filter(const Frame& F) {
    LAS float* zf = (LAS float*)F.lds;
    LAS float* h1 = zf + 16 * 36;
    LAS float* h2 = h1 + 16 * 64;
    float* HRAW = (float*)(F.ws + WS_HRAW); float* SUMSQ = (float*)(F.ws + WS_SUMSQ);
    const float* fr = F.in[I_FREQ];
    const __amdgpu_buffer_rsrc_t rW1 = __builtin_amdgcn_make_buffer_rsrc((void*)F.in[I_W1], 0, 0x7FFFFFFF, 0x00020000), rW2 = __builtin_amdgcn_make_buffer_rsrc((void*)F.in[I_W2], 0, 0x7FFFFFFF, 0x00020000),
                                 rW3 = __builtin_amdgcn_make_buffer_rsrc((void*)F.in[I_W3], 0, 0x7FFFFFFF, 0x00020000);
    for (int it = F.bid; it < 256; it += F.G) {
        const int t0 = it * 16;
        int tl_; asm volatile("v_mbcnt_lo_u32_b32 %0, -1, 0\n\tv_mbcnt_hi_u32_b32 %0, -1, %0" : "=v"(tl_)); const int tq = F.wave * 64 + tl_;
        __syncthreads();
        for (int e = tq; e < 16 * 33; e += NTHR) { const int tt = e / 33, i = e % 33, t = t0 + tt; float v;
            if (i == 0) v = (float)((double)t / 4095.0);
            else { const int j = (i - 1) & 15; const double f = 1e-4 + (double)j * ((15.0 - 1e-4) / 15.0); double rev = (double)t * f / 4096.0; rev -= floor(rev);
                v = (i <= 16) ? __builtin_amdgcn_cosf((float)rev) : -__builtin_amdgcn_sinf((float)rev); }
            zf[tt * 36 + i] = v; }
        __syncthreads();
        { const int j = tq & 63, tt0 = tq >> 6; const unsigned jo = (unsigned)j * 4u; float w1[33];
#pragma unroll
          for (int i = 0; i < 33; ++i) w1[i] = __uint_as_float(__builtin_amdgcn_raw_buffer_load_b32(rW1, (int)jo, i * 256, 0));
          const float b1 = F.in[I_B1][j], frj = fr[j];
#pragma unroll
          for (int p = 0; p < 2; ++p) { const int tt = tt0 + 8 * p; float a = b1;
#pragma unroll
            for (int i = 0; i < 33; ++i) a += zf[tt * 36 + i] * w1[i];
            h1[tt * 64 + j] = sinf(frj * a); } }
        __syncthreads();
        { const int j = tq & 63, tt0 = tq >> 6; const unsigned jo = (unsigned)j * 4u; float w2[64];
#pragma unroll
          for (int i = 0; i < 64; ++i) w2[i] = __uint_as_float(__builtin_amdgcn_raw_buffer_load_b32(rW2, (int)jo, i * 256, 0));
          const float b2 = F.in[I_B2][j], frj = fr[j];
#pragma unroll
          for (int p = 0; p < 2; ++p) { const int tt = tt0 + 8 * p; float a = b2;
#pragma unroll
            for (int i = 0; i < 64; ++i) a += h1[tt * 64 + i] * w2[i];
            h2[tt * 64 + j] = sinf(frj * a); } }
        __syncthreads();
        float acc[16][4];
#pragma unroll
        for (int tt = 0; tt < 16; ++tt)
#pragma unroll
            for (int q = 0; q < 4; ++q) acc[tt][q] = 0.f;
        { float wa[8][4], wb[8][4]; const unsigned to = (unsigned)tq * 4u;
#define FL_LOAD(W, K0) do { _Pragma("unroll") for (int kk = 0; kk < 8; ++kk) _Pragma("unroll") for (int q = 0; q < 4; ++q) W[kk][q] = __uint_as_float(__builtin_amdgcn_raw_buffer_load_b32(rW3, (int)to, (((K0) + kk) * 2048 + q * 512) * 4, 0)); } while (0)
#define FL_FMA(W, K0) do { _Pragma("unroll") for (int kk = 0; kk < 8; ++kk) { _Pragma("unroll") for (int tt = 0; tt < 16; ++tt) { const float hv = h2[tt * 64 + (K0) + kk]; \
            _Pragma("unroll") for (int q = 0; q < 4; ++q) acc[tt][q] += hv * W[kk][q]; } __builtin_amdgcn_sched_barrier(0); } } while (0)
          FL_LOAD(wa, 0);
          FL_LOAD(wb, 8);  __builtin_amdgcn_sched_barrier(0); FL_FMA(wa, 0);  FL_LOAD(wa, 16); __builtin_amdgcn_sched_barrier(0); FL_FMA(wb, 8);
          FL_LOAD(wb, 24); __builtin_amdgcn_sched_barrier(0); FL_FMA(wa, 16); FL_LOAD(wa, 32); __builtin_amdgcn_sched_barrier(0); FL_FMA(wb, 24);
          FL_LOAD(wb, 40); __builtin_amdgcn_sched_barrier(0); FL_FMA(wa, 32); FL_LOAD(wa, 48); __builtin_amdgcn_sched_barrier(0); FL_FMA(wb, 40);
          FL_LOAD(wb, 56); __builtin_amdgcn_sched_barrier(0); FL_FMA(wa, 48); FL_FMA(wb, 56);
#undef FL_LOAD
#undef FL_FMA
        }
#pragma unroll
        for (int q = 0; q < 4; ++q) { const int col = q * 512 + tq; const float dc = fabsf(F.in[I_DECAY][col]); float ss = 0.f;
#pragma unroll
            for (int tt = 0; tt < 16; ++tt) { const int t = t0 + tt; const float tn = (float)((double)t / 4095.0); const float v = acc[tt][q] * __builtin_amdgcn_exp2f(-1.4426950408889634f * tn * dc);
                acc[tt][q] = v; if (!(col >= 1024 && t == 0)) ss += v * v; }
#pragma unroll
            for (int t4 = 0; t4 < 4; ++t4) *(f32x4*)(HRAW + (size_t)col * 4096 + t0 + 4 * t4) = (f32x4){acc[4 * t4][q], acc[4 * t4 + 1][q], acc[4 * t4 + 2][q], acc[4 * t4 + 3][q]};
            SUMSQ[(size_t)it * 2048 + col] = ss; }
    }
}

template <int MODE>
__device__ void norm_proj32(const Frame& F, const float* X, const float* nw, const float* Wsrc, int wld, bf16_t* XNout) {
    constexpr int ROWB = 2064;
    LAS unsigned char* thi = F.lds; LAS unsigned char* tlo = F.lds + 32 * ROWB;
    LAS float* part = (LAS float*)F.lds;
    LAS float* logit = (LAS float*)(F.lds + 32768);
    const int lane = F.lane, w = F.wave;
    bf16x8 Bhi[8], Blo[8];
    { const int c = lane & 31, hh = lane >> 5;
#pragma unroll
      for (int ks = 0; ks < 8; ++ks) { const int k0 = 128 * w + 16 * ks + 8 * hh;
#pragma unroll
        for (int j = 0; j < 8; ++j) { const float v = Wsrc[(size_t)(k0 + j) * wld + c]; const bf16_t h = f2bf(v); const bf16_t l = f2bf(v - bf2f(h)); Bhi[ks][j] = (short)h; Blo[ks][j] = (short)l; } } }
    f32x4 nwv[2][2];
#pragma unroll
    for (int q2 = 0; q2 < 2; ++q2)
#pragma unroll
        for (int h = 0; h < 2; ++h) nwv[q2][h] = *(const f32x4*)(nw + 512 * q2 + 8 * lane + 4 * h);
    const int ngroups = T_ / 32, gpb = (ngroups + F.G - 1) / F.G;
    const int g_lo = F.bid * gpb, g_hi = (g_lo + gpb < ngroups) ? g_lo + gpb : ngroups;
    if (MODE == 1) { if (F.tid < 32) F.misc[MW_CNT + F.tid] = 0u; }
    __syncthreads();
    f32x4 xf[4][2][2]; u32x4 xh[4][2];
#define NP_ISSUE(GI) do { _Pragma("unroll") for (int i = 0; i < 4; ++i) { const size_t t = (size_t)(GI) * 32 + 4 * w + i; \
        _Pragma("unroll") for (int q2 = 0; q2 < 2; ++q2) { if (MODE == 0) { xf[i][q2][0] = *(const f32x4*)(X + t * 1024 + 512 * q2 + 8 * lane); xf[i][q2][1] = *(const f32x4*)(X + t * 1024 + 512 * q2 + 8 * lane + 4); } \
            else xh[i][q2] = *(const u32x4*)((const bf16_t*)X + t * 1024 + 512 * q2 + 8 * lane); } } } while (0)
    if (g_lo < g_hi) NP_ISSUE(g_lo);
    for (int gi = g_lo; gi < g_hi; ++gi) {
#pragma unroll
        for (int i = 0; i < 4; ++i) { const int tk = 4 * w + i; const size_t t = (size_t)gi * 32 + tk;
            f32x4 xv[2][2]; float ss = 0.f;
#pragma unroll
            for (int q2 = 0; q2 < 2; ++q2) { if (MODE == 0) { xv[q2][0] = xf[i][q2][0]; xv[q2][1] = xf[i][q2][1]; }
                else { const u32x4 hb = xh[i][q2]; xv[q2][0] = (f32x4){bflo(hb.x), bfhi(hb.x), bflo(hb.y), bfhi(hb.y)}; xv[q2][1] = (f32x4){bflo(hb.z), bfhi(hb.z), bflo(hb.w), bfhi(hb.w)}; }
#pragma unroll
                for (int h = 0; h < 2; ++h) ss += xv[q2][h][0] * xv[q2][h][0] + xv[q2][h][1] * xv[q2][h][1] + xv[q2][h][2] * xv[q2][h][2] + xv[q2][h][3] * xv[q2][h][3]; }
            ss = wave_sum(ss); const float rstd = rsqrtf(ss * (1.f / 1024.f) + 1e-6f);
#pragma unroll
            for (int q2 = 0; q2 < 2; ++q2) { unsigned hwd[4], lwd[4], f8[2];
#pragma unroll
                for (int h = 0; h < 2; ++h) { const f32x4 v = xv[q2][h] * rstd * nwv[q2][h];
                    bf16_t hh[4], ll[4];
#pragma unroll
                    for (int e = 0; e < 4; ++e) { hh[e] = f2bf(v[e]); ll[e] = f2bf(v[e] - bf2f(hh[e])); }
                    hwd[2 * h] = (unsigned)hh[0] | ((unsigned)hh[1] << 16); hwd[2 * h + 1] = (unsigned)hh[2] | ((unsigned)hh[3] << 16);
                    lwd[2 * h] = (unsigned)ll[0] | ((unsigned)ll[1] << 16); lwd[2 * h + 1] = (unsigned)ll[2] | ((unsigned)ll[3] << 16);
                    f8[h] = pk4_fp8(v[0], v[1], v[2], v[3]); }
                const u32x4 hw = (u32x4){hwd[0], hwd[1], hwd[2], hwd[3]}, lw = (u32x4){lwd[0], lwd[1], lwd[2], lwd[3]}; const u32x2 f8w = (u32x2){f8[0], f8[1]};
                const size_t co = t * 1024 + 512 * q2 + 8 * lane;
                if (MODE == 0) { *(u32x4*)(XNout + co) = hw; *(u32x2*)(F.ws + WS_XN8 + co) = f8w; } else *(u32x2*)((unsigned char*)XNout + co) = f8w;
                *(LAS u32x4*)(thi + tk * ROWB + (512 * q2 + 8 * lane) * 2) = hw; *(LAS u32x4*)(tlo + tk * ROWB + (512 * q2 + 8 * lane) * 2) = lw; } }
        if (gi + 1 < g_hi) NP_ISSUE(gi + 1);
        __syncthreads();
        f32x16 acc;
#pragma unroll
        for (int i = 0; i < 16; ++i) acc[i] = 0.f;
        { const int r = lane & 31, hh = lane >> 5;
#pragma unroll
          for (int ks = 0; ks < 8; ++ks) { const int off = r * ROWB + (128 * w + 16 * ks + 8 * hh) * 2;
            const bf16x8 ah = *(const LAS bf16x8*)(thi + off), al = *(const LAS bf16x8*)(tlo + off);
            acc = __builtin_amdgcn_mfma_f32_32x32x16_bf16(ah, Bhi[ks], acc, 0, 0, 0);
            acc = __builtin_amdgcn_mfma_f32_32x32x16_bf16(al, Bhi[ks], acc, 0, 0, 0);
            acc = __builtin_amdgcn_mfma_f32_32x32x16_bf16(ah, Blo[ks], acc, 0, 0, 0); } }
        __syncthreads();
#pragma unroll
        for (int i = 0; i < 16; ++i) part[(w * 16 + i) * 64 + lane] = acc[i];
        __syncthreads();
        for (int o = F.tid; o < 1024; o += NTHR) { const int reg = o >> 6, ln = o & 63; float s = 0.f;
#pragma unroll
            for (int ww = 0; ww < 8; ++ww) s += part[(ww * 16 + reg) * 64 + ln];
            const int row = (reg & 3) + 8 * (reg >> 2) + 4 * (ln >> 5), e = ln & 31;
            if (MODE == 0) ((float*)(F.ws + WS_ALOW))[((size_t)gi * 32 + row) * 32 + e] = s; else logit[row * 33 + e] = s; }
        if (MODE == 1) {
            __syncthreads();
            if (F.tid < 32) { const int tk = F.tid; float v[32];
#pragma unroll
                for (int e = 0; e < 32; ++e) v[e] = logit[tk * 33 + e] + F.in[I_RB][e];
                unsigned taken = 0u; float tv[4]; int te[4];
#pragma unroll
                for (int k = 0; k < 4; ++k) { float best = -3.4e38f; int bi = 0;
#pragma unroll
                    for (int e = 0; e < 32; ++e) { const bool ok = !((taken >> e) & 1u) && (v[e] > best); best = ok ? v[e] : best; bi = ok ? e : bi; }
                    taken |= 1u << bi; tv[k] = best; te[k] = bi; }
                float ex[4], sum = 0.f;
#pragma unroll
                for (int k = 0; k < 4; ++k) { ex[k] = expf(tv[k] - tv[0]); sum += ex[k]; }
                const int tl = (gi - g_lo) * 32 + tk;
#pragma unroll
                for (int k = 0; k < 4; ++k) { const unsigned lp = atomicAdd((unsigned*)&F.misc[MW_CNT + te[k]], 1u);
                    F.misc[MW_SEL + (tl * 4 + k) * 3 + 0] = (unsigned)te[k]; F.misc[MW_SEL + (tl * 4 + k) * 3 + 1] = lp; F.misc[MW_SEL + (tl * 4 + k) * 3 + 2] = __float_as_uint(ex[k] / sum); } }
        }
        __syncthreads();
    }
    if (MODE == 1) {
        unsigned* gcount = F.ctl + CW_GCOUNT;
        if (F.tid < 32) F.misc[MW_BASE + F.tid] = __hip_atomic_fetch_add(gcount + F.tid, F.misc[MW_CNT + F.tid], __ATOMIC_RELAXED, __HIP_MEMORY_SCOPE_AGENT);
        __syncthreads();
        const int ntl = (g_hi - g_lo) * 32 * 4;
        for (int i = F.tid; i < ntl; i += NTHR) { const unsigned e = F.misc[MW_SEL + i * 3], lp = F.misc[MW_SEL + i * 3 + 1], wb = F.misc[MW_SEL + i * 3 + 2];
            const size_t gidx = (size_t)g_lo * 32 * 4 + i;
            const unsigned pos = F.misc[MW_BASE + e] + lp;
            ((int*)(F.ws + WS_EIDX))[gidx] = (int)e; ((int*)(F.ws + WS_POSE))[gidx] = (int)pos; ((unsigned*)(F.ws + WS_WGT))[gidx] = wb;
            ((int*)(F.ws + WS_LIST))[(size_t)e * T_ + pos] = (int)(gidx >> 2); }
        __syncthreads();
    }
}

#undef NP_ISSUE
__device__ void p1_rnorm(const Frame& F) {
    const float* SUMSQ = (const float*)(F.ws + WS_SUMSQ); float* RN = (float*)(F.ws + WS_RN);
    LAS float* red = (LAS float*)F.lds;
    for (int c0 = F.bid * 4; c0 < 1024; c0 += F.G * 4) {
        const int c = c0 + (F.tid >> 7), j = F.tid & 127; float sv = 0.f;
        if (c < 1024) sv = (SUMSQ[(size_t)j * 2048 + c] + SUMSQ[(size_t)j * 2048 + 1024 + c]) + (SUMSQ[(size_t)(j + 128) * 2048 + c] + SUMSQ[(size_t)(j + 128) * 2048 + 1024 + c]);
        sv = wave_sum(sv);
        __syncthreads();
        if (F.lane == 0) red[F.wave] = sv;
        __syncthreads();
        if (F.tid < 4 && c0 + F.tid < 1024) RN[c0 + F.tid] = rsqrtf(red[2 * F.tid] + red[2 * F.tid + 1] + 1e-6f);
    }
    __syncthreads();
}
__device__ void p2_gla_prep(const Frame& F) {
    LAS float* al = (LAS float*)F.lds; LAS float* tot = al + 64 * 32;
    const bf16_t* PQ = (const bf16_t*)(F.ws + WS_PQKV); const float* ALOW = (const float*)(F.ws + WS_ALOW);
    bf16_t* QT = (bf16_t*)(F.ws + WS_QT); bf16_t* KT = (bf16_t*)(F.ws + WS_KT); bf16_t* KE = (bf16_t*)(F.ws + WS_KE); float* DEC = (float*)(F.ws + WS_DEC);
    const int dk = 2 * (F.tid & 63), tq = F.tid >> 6;
    const int pos = (dk & ~15) | swap23(dk & 15);
    const bool hconst = (F.G & 3) == 0; f32x2 w2H[2][16], gbH[2];
#pragma unroll
    for (int d = 0; d < 2; ++d) { gbH[d] = *(const f32x2*)(F.in[I_GB] + d * 512 + (F.bid & 3) * 128 + dk);
#pragma unroll
        for (int r = 0; r < 16; ++r) w2H[d][r] = *(const f32x2*)(F.in[I_GW2] + (d * 16 + r) * 512 + (F.bid & 3) * 128 + dk); }
    for (int it = F.bid; it < 2048; it += F.G) {
        const int h = it & 3, n = (it >> 2) & 63, b = it >> 8; const size_t grow0 = (size_t)b * L_ + 64 * n;
        __syncthreads();
        { const int row = F.tid >> 3, c4 = (F.tid & 7) * 4; *(LAS f32x4*)(al + row * 32 + c4) = *(const f32x4*)(ALOW + (grow0 + row) * 32 + c4); }
        unsigned qraw[8], kraw[8];
#pragma unroll
        for (int ii = 0; ii < 8; ++ii) { const size_t g = (grow0 + tq * 8 + ii) * 2048; qraw[ii] = *(const unsigned*)(PQ + g + h * 128 + dk); kraw[ii] = *(const unsigned*)(PQ + g + 512 + h * 128 + dk); }
        __syncthreads();
#pragma unroll
        for (int d = 0; d < 2; ++d) {
            f32x2 c[8];
            { f32x2 w2r[16]; f32x2 gb;
              if (hconst) { gb = gbH[d];
#pragma unroll
                for (int r = 0; r < 16; ++r) w2r[r] = w2H[d][r]; }
              else { gb = *(const f32x2*)(F.in[I_GB] + d * 512 + h * 128 + dk);
#pragma unroll
                for (int r = 0; r < 16; ++r) w2r[r] = *(const f32x2*)(F.in[I_GW2] + (d * 16 + r) * 512 + h * 128 + dk); }
#pragma unroll
              for (int ii = 0; ii < 8; ++ii) { const int i = tq * 8 + ii; f32x2 l2 = gb;
#pragma unroll
                for (int r4 = 0; r4 < 16; r4 += 4) { const f32x4 a0 = *(const LAS f32x4*)(al + i * 32 + d * 16 + r4);
#pragma unroll
                    for (int e = 0; e < 4; ++e) l2 = __builtin_elementwise_fma((f32x2){a0[e], a0[e]}, w2r[r4 + e], l2); }
                c[ii][0] = (fminf(l2[0], 0.f) - 0.6931471805599453f * __builtin_amdgcn_logf(1.f + __builtin_amdgcn_exp2f(-1.4426950408889634f * fabsf(l2[0])))) * (1.f / 16.f);
                c[ii][1] = (fminf(l2[1], 0.f) - 0.6931471805599453f * __builtin_amdgcn_logf(1.f + __builtin_amdgcn_exp2f(-1.4426950408889634f * fabsf(l2[1])))) * (1.f / 16.f); } }
            if (d == 0) {
#pragma unroll
                for (int ii = 1; ii < 8; ++ii) c[ii] += c[ii - 1];
            } else {
#pragma unroll
                for (int ii = 6; ii >= 0; --ii) c[ii] += c[ii + 1];
            }
            __syncthreads();
            *(LAS f32x2*)(tot + tq * 128 + dk) = d == 0 ? c[7] : c[0];
            __syncthreads();
            f32x2 off = (f32x2){0.f, 0.f}, total = (f32x2){0.f, 0.f};
#pragma unroll
            for (int t2 = 0; t2 < 8; ++t2) { const f32x2 a = *(const LAS f32x2*)(tot + t2 * 128 + dk); total += a; if (d == 0 ? (t2 < tq) : (t2 > tq)) off += a; }
            const size_t cb = (size_t)(((d * 8 + b) * 4 + h) * 64 + n);
            bf16_t* qd = QT + (cb * 64 + tq * 8) * 128 + pos; bf16_t* kd = KT + (cb * 64 + tq * 8) * 128 + pos;
            f32x2 ke[8];
            const f32x2 etot = (f32x2){__builtin_amdgcn_exp2f(1.4426950408889634f * total[0]), __builtin_amdgcn_exp2f(1.4426950408889634f * total[1])};
#pragma unroll
            for (int ii = 0; ii < 8; ++ii) { const f32x2 qv = (f32x2){bflo(qraw[ii]), bfhi(qraw[ii])}, kv = (f32x2){bflo(kraw[ii]), bfhi(kraw[ii])}; const f32x2 bb2 = (c[ii] + off) * 1.4426950408889634f;
                const f32x2 ep = (f32x2){__builtin_amdgcn_exp2f(bb2[0]), __builtin_amdgcn_exp2f(bb2[1])}, em = (f32x2){__builtin_amdgcn_exp2f(-bb2[0]), __builtin_amdgcn_exp2f(-bb2[1])};
                const f32x2 qdec = qv * ep, kdec = kv * em;
                *(unsigned*)(qd + ii * 128) = pk2(qdec[0], qdec[1]); *(unsigned*)(kd + ii * 128) = pk2(kdec[0], kdec[1]); ke[ii] = kdec * etot;
                if ((ii & 3) == 3) __builtin_amdgcn_sched_barrier(0); }
#pragma unroll
            for (int j = 0; j < 2; ++j) { bf16_t* kr = KE + (cb * 128 + dk + j) * 64 + 16 * (tq >> 1) + 4 * (tq & 1);
                u32x2 wa, wb; wa.x = pk2(ke[0][j], ke[1][j]); wa.y = pk2(ke[2][j], ke[3][j]); wb.x = pk2(ke[4][j], ke[5][j]); wb.y = pk2(ke[6][j], ke[7][j]);
                *(u32x2*)kr = wa; *(u32x2*)(kr + 8) = wb; }
            if (tq == 0) *(f32x2*)(DEC + cb * 128 + dk) = etot;
            __builtin_amdgcn_sched_barrier(0);
        }
    }
}

constexpr int GS_QT = 0, GS_KT = 16384, GS_KE = 32768, GS_DEC = 49152, GS_SLOT = 50176, GS_V = 2 * GS_SLOT, GS_O = GS_V + 32768;
__device__ __forceinline__ void gla_dma(const Frame& F, LAS unsigned char* slot, __amdgpu_buffer_rsrc_t rR1, unsigned soffR1, const unsigned (&goff)[6], __amdgpu_buffer_rsrc_t rDEC, unsigned soffDEC, __amdgpu_buffer_rsrc_t rVT, unsigned soffVT, const unsigned (&voff)[4]) {
#pragma unroll
    for (int j = 0; j < 4; ++j) __builtin_amdgcn_raw_ptr_buffer_load_lds(rVT, (LAS void*)(F.lds + GS_V + F.wave * 4096 + j * 1024), 16, voff[j], (int)soffVT, 0, 0);
#pragma unroll
    for (int j = 0; j < 6; ++j) __builtin_amdgcn_raw_ptr_buffer_load_lds(rR1, (LAS void*)(slot + (F.wave * 6 + j) * 1024), 16, goff[j], (int)soffR1, 0, 0);
    if (F.wave == 0) __builtin_amdgcn_raw_ptr_buffer_load_lds(rDEC, (LAS void*)(slot + GS_DEC), 16, 16u * (unsigned)F.lane, (int)soffDEC, 0, 0);
}
__device__ void p3_gla_scan(const Frame& F) {
    if (F.bid >= 64) return;
    const int dir = F.bid & 1, h = (F.bid >> 1) & 3, b = F.bid >> 3, vb = F.wave, l31 = F.lane & 31, hh = F.lane >> 5;
    const __amdgpu_buffer_rsrc_t rR1 = __builtin_amdgcn_make_buffer_rsrc((void*)(F.ws + WS_R1), 0, 0x7FFFFFFF, 0x00020000), rVT = __builtin_amdgcn_make_buffer_rsrc((void*)(F.ws + WS_PQKV), 0, 0x7FFFFFFF, 0x00020000),
                                 rDEC = __builtin_amdgcn_make_buffer_rsrc((void*)(F.ws + WS_DEC), 0, 0x7FFFFFFF, 0x00020000);
    bf16_t* O = (bf16_t*)(F.ws + (dir ? WS_OB : WS_OF));
    unsigned goff[6], voff[4];
#pragma unroll
    for (int j = 0; j < 6; ++j) { const int pi = F.wave * 6 + j, arr = pi >> 4, p = pi & 15, l = F.lane;
        if (arr < 2) { const int row = 4 * p + (l >> 4), cpos = l & 15; goff[j] = (unsigned)arr * (64u << 20) + (unsigned)(row * 256 + 16 * (cpos ^ (row & 15))); }
        else { const int row = 8 * p + (l >> 3), cpos = l & 7; goff[j] = (128u << 20) + (unsigned)(row * 128 + 16 * (cpos ^ ((row >> 1) & 7))); } }
#pragma unroll
    for (int j = 0; j < 4; ++j) voff[j] = (unsigned)((16 * j + (F.lane >> 2)) * 4096 + (1024 + h * 256 + 32 * vb) * 2 + 16 * (F.lane & 3));
    f32x16 S[4];
#pragma unroll
    for (int kb = 0; kb < 4; ++kb)
#pragma unroll
        for (int i = 0; i < 16; ++i) S[kb][i] = 0.f;
    const size_t cbase = (size_t)(((dir * 8 + b) * 4 + h) * 64);
    { const int n0 = dir ? 63 : 0; const size_t cb = cbase + n0;
      gla_dma(F, F.lds, rR1, (unsigned)cb * 16384u, goff, rDEC, (unsigned)cb * 512u, rVT, (unsigned)(b * L_ + 64 * n0) * 4096u, voff); }
    asm volatile("s_waitcnt vmcnt(0)" ::: "memory");
    __builtin_amdgcn_s_barrier();
    const int r15 = l31 & 15;
    const LAS unsigned char* vcol = F.lds + GS_V + F.wave * 4096 + l31 * 2;
    const int vsw = (l31 >> 1) & 7;
    for (int cs = 0; cs < 64; ++cs) {
        const int n = dir ? 63 - cs : cs;
        bf16x8 vf[4];
#pragma unroll
        for (int s4 = 0; s4 < 4; ++s4) { unsigned short e[8];
#pragma unroll
            for (int i = 0; i < 4; ++i) { e[i] = *(const LAS bf16_t*)(vcol + (16 * s4 + 4 * hh + i) * 64); e[4 + i] = *(const LAS bf16_t*)(vcol + (16 * s4 + 8 + 4 * hh + i) * 64); }
            u32x4 w; w.x = e[0] | ((unsigned)e[1] << 16); w.y = e[2] | ((unsigned)e[3] << 16); w.z = e[4] | ((unsigned)e[5] << 16); w.w = e[6] | ((unsigned)e[7] << 16);
            vf[s4] = __builtin_bit_cast(bf16x8, w); }
        asm volatile("s_waitcnt lgkmcnt(0)" ::: "memory");
        __builtin_amdgcn_sched_barrier(0);
        if (cs + 1 < 64) { const int n1 = dir ? 62 - cs : cs + 1; const size_t cb = cbase + n1;
            gla_dma(F, F.lds + ((cs + 1) & 1) * GS_SLOT, rR1, (unsigned)cb * 16384u, goff, rDEC, (unsigned)cb * 512u, rVT, (unsigned)(b * L_ + 64 * n1) * 4096u, voff); }
        __builtin_amdgcn_sched_barrier(0);
        const LAS unsigned char* sl = F.lds + (cs & 1) * GS_SLOT;
        const LAS unsigned char* qrow = sl + GS_QT + l31 * 256; const LAS unsigned char* krow = sl + GS_KT + l31 * 256;
#pragma unroll
        for (int ib = 0; ib < 2; ++ib) {
            const bool has_off = dir ? (ib == 0) : (ib == 1);
            const int jo = dir ? 1 : 0;
            f32x16 sa, sb;
#pragma unroll
            for (int i = 0; i < 16; ++i) { sa[i] = 0.f; sb[i] = 0.f; }
            bf16x8 qn = *(const LAS bf16x8*)(qrow + ib * 8192 + 16 * (hh ^ r15)), kdn = *(const LAS bf16x8*)(krow + ib * 8192 + 16 * (hh ^ r15)), kon = kdn;
            if (has_off) kon = *(const LAS bf16x8*)(krow + jo * 8192 + 16 * (hh ^ r15));
#pragma unroll
            for (int s8 = 0; s8 < 8; ++s8) { const bf16x8 q = qn, kd = kdn, ko = kon;
                if (s8 < 7) { const int sw = 16 * ((2 * s8 + 2 + hh) ^ r15);
                    qn = *(const LAS bf16x8*)(qrow + ib * 8192 + sw); kdn = *(const LAS bf16x8*)(krow + ib * 8192 + sw);
                    if (has_off) kon = *(const LAS bf16x8*)(krow + jo * 8192 + sw); }
                sa = __builtin_amdgcn_mfma_f32_32x32x16_bf16(kd, q, sa, 0, 0, 0);
                if (has_off) sb = __builtin_amdgcn_mfma_f32_32x32x16_bf16(ko, q, sb, 0, 0, 0);
                __builtin_amdgcn_sched_barrier(0); }
            bf16x8 q0n = *(const LAS bf16x8*)(qrow + ib * 8192 + 16 * (hh ^ r15)), q1n = *(const LAS bf16x8*)(qrow + ib * 8192 + 16 * ((2 + hh) ^ r15));
#pragma unroll
            for (int reg = 0; reg < 16; ++reg) { const int jl = (reg & 3) + 8 * (reg >> 2) + 4 * hh; const bool keep = (dir == 0) ? (jl <= l31) : (jl > l31); sa[reg] = keep ? sa[reg] : 0.f; }
            f32x16 o;
#pragma unroll
            for (int i = 0; i < 16; ++i) o[i] = 0.f;
            o = __builtin_amdgcn_mfma_f32_32x32x16_bf16(pack8(sa, 0), vf[2 * ib], o, 0, 0, 0);
            o = __builtin_amdgcn_mfma_f32_32x32x16_bf16(pack8(sa, 8), vf[2 * ib + 1], o, 0, 0, 0);
            if (has_off) {
                const bf16x8 vo0 = dir ? vf[2] : vf[0], vo1 = dir ? vf[3] : vf[1];
                o = __builtin_amdgcn_mfma_f32_32x32x16_bf16(pack8(sb, 0), vo0, o, 0, 0, 0);
                o = __builtin_amdgcn_mfma_f32_32x32x16_bf16(pack8(sb, 8), vo1, o, 0, 0, 0); }
            __builtin_amdgcn_sched_barrier(0);
#pragma unroll
            for (int kb = 0; kb < 4; ++kb) { const bf16x8 q0 = q0n, q1 = q1n;
                if (kb < 3) { q0n = *(const LAS bf16x8*)(qrow + ib * 8192 + 16 * ((4 * kb + 4 + hh) ^ r15)); q1n = *(const LAS bf16x8*)(qrow + ib * 8192 + 16 * ((4 * kb + 6 + hh) ^ r15)); }
                o = __builtin_amdgcn_mfma_f32_32x32x16_bf16(q0, pack8(S[kb], 0), o, 0, 0, 0);
                o = __builtin_amdgcn_mfma_f32_32x32x16_bf16(q1, pack8(S[kb], 8), o, 0, 0, 0);
                __builtin_amdgcn_sched_barrier(0);
            }
            { LAS unsigned char* ost = F.lds + GS_O + F.wave * 2048;
#pragma unroll
              for (int reg = 0; reg < 16; ++reg) *(LAS bf16_t*)(ost + ((reg & 3) + 8 * (reg >> 2) + 4 * hh) * 64 + l31 * 2) = f2bf(o[reg]);
#pragma unroll
              for (int j = 0; j < 2; ++j) { const int pc = F.lane + 64 * j, row = pc >> 2, part = pc & 3;
                  *(u32x4*)(O + ((size_t)b * L_ + 64 * n + 32 * ib + row) * 1024 + h * 256 + 32 * vb + 8 * part) = *(const LAS u32x4*)(ost + row * 64 + part * 16); } }
            __builtin_amdgcn_sched_barrier(0);
        }
        {
          const LAS unsigned char* kerow = sl + GS_KE + l31 * 128; const LAS unsigned char* decp = sl + GS_DEC + 16 * hh;
          bf16x8 ken = *(const LAS bf16x8*)(kerow + 16 * (hh ^ vsw));
          f32x4 dn[4];
#pragma unroll
          for (int g = 0; g < 4; ++g) dn[g] = *(const LAS f32x4*)(decp + 32 * g);
#pragma unroll
          for (int kb = 0; kb < 4; ++kb) {
#pragma unroll
            for (int g = 0; g < 4; ++g)
#pragma unroll
                for (int e = 0; e < 4; ++e) S[kb][4 * g + e] *= dn[g][e];
            if (kb < 3) {
#pragma unroll
                for (int g = 0; g < 4; ++g) dn[g] = *(const LAS f32x4*)(decp + 128 * (kb + 1) + 32 * g); }
#pragma unroll
            for (int s4 = 0; s4 < 4; ++s4) { const bf16x8 kef = ken; const int st = kb * 4 + s4 + 1;
                if (st < 16) ken = *(const LAS bf16x8*)(kerow + (st >> 2) * 4096 + 16 * ((2 * (st & 3) + hh) ^ vsw));
                S[kb] = __builtin_amdgcn_mfma_f32_32x32x16_bf16(kef, vf[s4], S[kb], 0, 0, 0);
                __builtin_amdgcn_sched_barrier(0); }
          }
        }
        asm volatile("s_waitcnt vmcnt(4)\n\ts_waitcnt lgkmcnt(0)" ::: "memory");
        __builtin_amdgcn_s_barrier();
    }
    asm volatile("s_waitcnt vmcnt(0)" ::: "memory");
    __syncthreads();
}

__device__ void p4_conv_mfma(const Frame& F, int qsel) {
    constexpr int RS = 10560;
    LAS unsigned char* Rl = F.lds; LAS unsigned char* Zl = F.lds + 65536;
    const float* HRAWT = (const float*)(F.ws + WS_HRAW); const float* RN = (const float*)(F.ws + WS_RN); const bf16_t* XT = (const bf16_t*)(F.ws + WS_PHY); bf16_t* YT = (bf16_t*)(F.ws + WS_YT);
    const int lane = F.lane, g = F.wave >> 2, qp = F.wave & 3, q1 = 2 * qp + 1, cn = lane & 31, T1l = cn >> 3, b = cn & 7, hh = lane >> 5, r = lane & 31;
    __syncthreads();
    const int base_b = b * RS + 272 * T1l + 16 * hh;
    const int base_a = 2 * (4096 - 128 * (4 * q1 + 3) + 8 * hh - 4 * r);
    for (;;) {
        __syncthreads();
        if (F.tid == 0) F.misc[MW_Q] = __hip_atomic_fetch_add(F.ctl + CW_CONVQ + 64 * qsel, 1u, __ATOMIC_RELAXED, __HIP_MEMORY_SCOPE_AGENT);
        __syncthreads();
        const int cq = (int)F.misc[MW_Q];
        if (cq >= (PROBE_PHASE == 32 ? 2048 : 1024)) break;
        const int c = cq & 1023;
        for (int ch = F.tid; ch < 768; ch += NTHR) { const int bb = ch / 96, k = ch % 96, idx8 = k < 48 ? 8 * k : 4480 + 8 * (k - 48);
            *(LAS u32x4*)(Zl + bb * RS + 2 * idx8 + 16 * (idx8 >> 7)) = (u32x4){0u, 0u, 0u, 0u}; }
        { int ln; asm volatile("v_mbcnt_lo_u32_b32 %0, -1, 0\n\tv_mbcnt_hi_u32_b32 %0, -1, %0" : "=v"(ln)); const int tq = F.wave * 64 + ln;
          const float* gfw = HRAWT + (size_t)c * 4096; const float* gbw = HRAWT + (size_t)(1024 + c) * 4096; const float rn = RN[c], bi = F.in[I_HBIAS][c];
          f32x4 vf[2], vb[2];
#pragma unroll
          for (int k = 0; k < 2; ++k) { vf[k] = *(const f32x4*)(gfw + (tq + NTHR * k) * 4); vb[k] = *(const f32x4*)(gbw + (tq + NTHR * k) * 4); }
          { const bf16_t* x1p = XT + (size_t)c * T_; const bf16_t* vvp = XT + (size_t)(1024 + c) * T_;
            const float* cw = F.in[I_CW]; const float* cb = F.in[I_CB];
            const float wa0 = cw[1024 + c], wa1 = cw[3072 + 1024 + c], wa2 = cw[2 * 3072 + 1024 + c], ba = cb[1024 + c];
            const float wv0 = cw[2048 + c], wv1 = cw[3072 + 2048 + c], wv2 = cw[2 * 3072 + 2048 + c], bv = cb[2048 + c];
            u32x4 xr[8], vr[8];
            LAS unsigned* edgeF = (LAS unsigned*)(Zl + 8 * RS); LAS unsigned* edgeL = edgeF + 64;
#pragma unroll
            for (int k = 0; k < 8; ++k) { const size_t g0 = (size_t)k * 4096 + 8 * tq;
                xr[k] = *(const u32x4*)(x1p + g0); vr[k] = *(const u32x4*)(vvp + g0); }
            if (ln == 0) {
#pragma unroll
                for (int k = 0; k < 8; ++k) edgeF[k * 8 + F.wave] = (xr[k].x & 0xffffu) | (vr[k].x << 16); }
            if (ln == 63) {
#pragma unroll
                for (int k = 0; k < 8; ++k) edgeL[k * 8 + F.wave] = (xr[k].w >> 16) | (vr[k].w & 0xffff0000u); }
            __syncthreads();
            const int wl = F.wave > 0 ? F.wave - 1 : 0, wn = F.wave < 7 ? F.wave + 1 : 7;
#pragma unroll
            for (int k = 0; k < 8; ++k) { const int bb = k, idx = 8 * tq + 384;
                const unsigned xlu = (unsigned)__builtin_amdgcn_update_dpp(0, (int)xr[k].w, 0x138, 0xf, 0xf, false), xru = (unsigned)__builtin_amdgcn_update_dpp(0, (int)xr[k].x, 0x130, 0xf, 0xf, false),
                               vlu = (unsigned)__builtin_amdgcn_update_dpp(0, (int)vr[k].w, 0x138, 0xf, 0xf, false), vru = (unsigned)__builtin_amdgcn_update_dpp(0, (int)vr[k].x, 0x130, 0xf, 0xf, false);
                const unsigned el = F.wave > 0 ? edgeL[k * 8 + wl] : 0u, ef = F.wave < 7 ? edgeF[k * 8 + wn] : 0u;
                float xe[10], ve[10];
                xe[0] = ln == 0 ? __uint_as_float(el << 16) : bfhi(xlu); ve[0] = ln == 0 ? __uint_as_float(el & 0xffff0000u) : bfhi(vlu);
                xe[9] = ln == 63 ? __uint_as_float(ef << 16) : bflo(xru); ve[9] = ln == 63 ? __uint_as_float(ef & 0xffff0000u) : bflo(vru);
                xe[1] = bflo(xr[k].x); xe[2] = bfhi(xr[k].x); xe[3] = bflo(xr[k].y); xe[4] = bfhi(xr[k].y); xe[5] = bflo(xr[k].z); xe[6] = bfhi(xr[k].z); xe[7] = bflo(xr[k].w); xe[8] = bfhi(xr[k].w);
                ve[1] = bflo(vr[k].x); ve[2] = bfhi(vr[k].x); ve[3] = bflo(vr[k].y); ve[4] = bfhi(vr[k].y); ve[5] = bflo(vr[k].z); ve[6] = bfhi(vr[k].z); ve[7] = bflo(vr[k].w); ve[8] = bfhi(vr[k].w);
                float zz[8];
#pragma unroll
                for (int e = 0; e < 8; ++e) zz[e] = (wv0 * ve[e] + wv1 * ve[e + 1] + wv2 * ve[e + 2] + bv) * (wa0 * xe[e] + wa1 * xe[e + 1] + wa2 * xe[e + 2] + ba);
                u32x4 zw; zw.x = pk2(zz[0], zz[1]); zw.y = pk2(zz[2], zz[3]); zw.z = pk2(zz[4], zz[5]); zw.w = pk2(zz[6], zz[7]);
                *(LAS u32x4*)(Zl + bb * RS + 2 * idx + 16 * (idx >> 7)) = zw; } }
#pragma unroll
          for (int k = 0; k < 2; ++k)
#pragma unroll
            for (int e = 0; e < 4; ++e) { const int d = (tq + NTHR * k) * 4 + e; float v = vf[k][e] * rn; if (d == 0) v += bi; const bf16_t hv = f2bf(v), hb = f2bf(vb[k][e] * rn);
#pragma unroll
                for (int m = 0; m < 4; ++m) { *(LAS bf16_t*)(Rl + m * 16384 + 2 * (m + 4096 - d)) = hv;
                    const int ib = m + 4096 + d; if (d >= 1 && ib < 8192) *(LAS bf16_t*)(Rl + m * 16384 + 2 * ib) = hb; } } }
        __syncthreads();
        f32x16 acc0[4], acc1[4];
#pragma unroll
        for (int m = 0; m < 4; ++m)
#pragma unroll
            for (int i = 0; i < 16; ++i) { acc0[m][i] = 0.f; acc1[m][i] = 0.f; }
#define CONV_STEPS(JLO, JHI, DO0, DO1) do { const LAS unsigned char* pa = Rl + base_a + 32 * (JLO); const LAS unsigned char* pb1 = Zl + base_b + 272 * ((JLO) >> 3); \
        for (int jo = (JLO); jo < (JHI); jo += 8) { \
            _Pragma("unroll") for (int ki = 0; ki < 8; ++ki) { \
                bf16x8 bf1, bf0; if (DO1) bf1 = *(const LAS bf16x8*)(pb1 + 32 * ki); if (DO0) bf0 = *(const LAS bf16x8*)(pb1 - 1088 + 32 * ki); \
                _Pragma("unroll") for (int m = 0; m < 4; ++m) { const u32x2 lo = *(const LAS u32x2*)(pa + m * 16384 + 32 * ki), hi = *(const LAS u32x2*)(pa + m * 16384 + 32 * ki + 8); \
                    u32x4 av; av.x = lo.x; av.y = lo.y; av.z = hi.x; av.w = hi.y; const bf16x8 af = __builtin_bit_cast(bf16x8, av); \
                    if (DO1) acc1[m] = __builtin_amdgcn_mfma_f32_32x32x16_bf16(af, bf1, acc1[m], 0, 0, 0); \
                    if (DO0) acc0[m] = __builtin_amdgcn_mfma_f32_32x32x16_bf16(af, bf0, acc0[m], 0, 0, 0); } } \
            pa += 256; pb1 += 272; } } while (0)
        if (g == 0) { CONV_STEPS(0, 32, false, true); CONV_STEPS(32, 160, true, true); }
        else        { CONV_STEPS(160, 280, true, true); CONV_STEPS(280, 312, true, false); }
#undef CONV_STEPS
        __syncthreads();
        { LAS unsigned char* part = F.lds + qp * 32768 + lane * 16;
          if (g == 1) {
#pragma unroll
            for (int m = 0; m < 4; ++m)
#pragma unroll
                for (int v4 = 0; v4 < 4; ++v4) { *(LAS f32x4*)(part + ((0 * 4 + m) * 4 + v4) * 1024) = (f32x4){acc0[m][4 * v4], acc0[m][4 * v4 + 1], acc0[m][4 * v4 + 2], acc0[m][4 * v4 + 3]};
                    *(LAS f32x4*)(part + ((1 * 4 + m) * 4 + v4) * 1024) = (f32x4){acc1[m][4 * v4], acc1[m][4 * v4 + 1], acc1[m][4 * v4 + 2], acc1[m][4 * v4 + 3]}; } }
          __syncthreads();
          if (g == 0) {
#pragma unroll
            for (int m = 0; m < 4; ++m)
#pragma unroll
                for (int v4 = 0; v4 < 4; ++v4) { const f32x4 p0 = *(const LAS f32x4*)(part + ((0 * 4 + m) * 4 + v4) * 1024), p1 = *(const LAS f32x4*)(part + ((1 * 4 + m) * 4 + v4) * 1024);
#pragma unroll
                    for (int e = 0; e < 4; ++e) { acc0[m][4 * v4 + e] += p0[e]; acc1[m][4 * v4 + e] += p1[e]; } } }
          __syncthreads(); }
        if (g == 0) {
#pragma unroll
            for (int reg = 0; reg < 16; ++reg) { const int rp = (reg & 3) + 8 * (reg >> 2) + 4 * hh;
                { const int idx = 128 * (4 * (q1 - 1) + T1l) + 4 * rp + 384; u32x2 wv; wv.x = pk2(acc0[0][reg], acc0[1][reg]); wv.y = pk2(acc0[2][reg], acc0[3][reg]); *(LAS u32x2*)(Zl + b * RS + 2 * idx + 16 * (idx >> 7)) = wv; }
                { const int idx = 128 * (4 * q1 + T1l) + 4 * rp + 384; u32x2 wv; wv.x = pk2(acc1[0][reg], acc1[1][reg]); wv.y = pk2(acc1[2][reg], acc1[3][reg]); *(LAS u32x2*)(Zl + b * RS + 2 * idx + 16 * (idx >> 7)) = wv; } } }
        __syncthreads();
#pragma unroll
        for (int k = 0; k < 8; ++k) { const int chunk = F.tid + NTHR * k, bb = chunk >> 9, idx = (chunk & 511) * 8 + 384;
            *(u32x4*)(YT + ((size_t)c * 8 + bb) * 4096 + (chunk & 511) * 8) = *(const LAS u32x4*)(Zl + bb * RS + 2 * idx + 16 * (idx >> 7)); }
    }
    __syncthreads();
}

__device__ void p5_finish(const Frame& F) {
    const bf16_t* OF = (const bf16_t*)(F.ws + WS_OF); const bf16_t* OB = (const bf16_t*)(F.ws + WS_OB); const bf16_t* PR = (const bf16_t*)(F.ws + WS_PR);
    bf16_t* OG = (bf16_t*)(F.ws + WS_OGLA);
    const int lane = F.lane;
    { const int sr = lane >> 4, l16 = lane & 15;
      f32x4 gn[4];
#pragma unroll
      for (int q = 0; q < 4; ++q) gn[q] = *(const f32x4*)(F.in[I_GNW] + 16 * l16 + 4 * q);
      for (int row0 = (F.bid * 8 + F.wave) * 8; row0 < T_ * 4; row0 += F.G * 8 * 8) {
        u32x4 a[2][2], b[2][2], r[2][2];
#pragma unroll
        for (int j = 0; j < 2; ++j) { const size_t o = (size_t)(row0 + 4 * j + sr) * 256 + 16 * l16;
#pragma unroll
            for (int h = 0; h < 2; ++h) { a[j][h] = *(const u32x4*)(OF + o + 8 * h); b[j][h] = *(const u32x4*)(OB + o + 8 * h); r[j][h] = *(const u32x4*)(PR + o + 8 * h); } }
#pragma unroll
        for (int j = 0; j < 2; ++j) { const size_t o = (size_t)(row0 + 4 * j + sr) * 256 + 16 * l16;
            float v[16], rr[16]; float ss = 0.f;
#pragma unroll
            for (int h = 0; h < 2; ++h) { const unsigned aw[4] = {a[j][h].x, a[j][h].y, a[j][h].z, a[j][h].w}, bw[4] = {b[j][h].x, b[j][h].y, b[j][h].z, b[j][h].w}, rw[4] = {r[j][h].x, r[j][h].y, r[j][h].z, r[j][h].w};
#pragma unroll
                for (int d = 0; d < 4; ++d) { v[8 * h + 2 * d] = bflo(aw[d]) + bflo(bw[d]); v[8 * h + 2 * d + 1] = bfhi(aw[d]) + bfhi(bw[d]); rr[8 * h + 2 * d] = bflo(rw[d]); rr[8 * h + 2 * d + 1] = bfhi(rw[d]); } }
#pragma unroll
            for (int e = 0; e < 16; ++e) ss += v[e] * v[e];
#define FG_DPP(CTRL) ss += __int_as_float(__builtin_amdgcn_update_dpp(0, __float_as_int(ss), CTRL, 0xf, 0xf, false))
            FG_DPP(0xB1); FG_DPP(0x4E); FG_DPP(0x141); FG_DPP(0x140);
#undef FG_DPP
            const float rstd = rsqrtf(ss * (1.f / 256.f) + 1e-6f);
            float ov[16];
#pragma unroll
            for (int e = 0; e < 16; ++e) { const float on = v[e] * rstd * gn[e >> 2][e & 3]; ov[e] = on * (rr[e] * sigmoidf_(rr[e])); }
#pragma unroll
            for (int h = 0; h < 2; ++h) { u32x4 w; w.x = pk2(ov[8 * h], ov[8 * h + 1]); w.y = pk2(ov[8 * h + 2], ov[8 * h + 3]); w.z = pk2(ov[8 * h + 4], ov[8 * h + 5]); w.w = pk2(ov[8 * h + 6], ov[8 * h + 7]);
                *(u32x4*)(OG + o + 8 * h) = w; } }
      } }
    { constexpr int RSZ = 2052; LAS unsigned char* zt = F.lds;
      const bf16_t* YT = (const bf16_t*)(F.ws + WS_YT); const bf16_t* X0C = (const bf16_t*)(F.ws + WS_X0C); bf16_t* OH = (bf16_t*)(F.ws + WS_OHY);
      const int c0 = (F.tid & 127) * 8;
      f32x4 w0[2], w1[2], w2[2], bz[2];
#pragma unroll
      for (int h = 0; h < 2; ++h) { w0[h] = *(const f32x4*)(F.in[I_CW] + c0 + 4 * h); w1[h] = *(const f32x4*)(F.in[I_CW] + 3072 + c0 + 4 * h); w2[h] = *(const f32x4*)(F.in[I_CW] + 6144 + c0 + 4 * h); bz[h] = *(const f32x4*)(F.in[I_CB] + c0 + 4 * h); }
      for (int it = F.bid; it < T_ / 64; it += F.G) {
        const int bq = (it * 64) >> 12, tq0 = (it * 64) & 4095;
#define FH_ISSUE(XR, BT) do { const int tl0_ = th * 16 + 8 * (BT); const size_t t0_ = (size_t)it * 64 + tl0_; const int tt0_ = (int)(t0_ & 4095); \
            _Pragma("unroll") for (int rI = 0; rI < 10; ++rI) { const int tt = tt0_ - 1 + rI; u32x4 v = (u32x4){0u, 0u, 0u, 0u}; if (tt >= 0 && tt < 4096) v = *(const u32x4*)(X0C + (t0_ - 1 + rI) * 1024 + c0); XR[rI] = v; } } while (0)
#define FH_COMP(XR, BT) do { const int tl0_ = th * 16 + 8 * (BT); const size_t t0_ = (size_t)it * 64 + tl0_; \
            _Pragma("unroll") for (int sI = 0; sI < 8; ++sI) { const LAS unsigned* zp = (const LAS unsigned*)(zt + (tl0_ + sI) * RSZ + c0 * 2); const unsigned yw[4] = {zp[0], zp[1], zp[2], zp[3]}; \
                const unsigned xp[4] = {XR[sI].x, XR[sI].y, XR[sI].z, XR[sI].w}, xc[4] = {XR[sI + 1].x, XR[sI + 1].y, XR[sI + 1].z, XR[sI + 1].w}, xn[4] = {XR[sI + 2].x, XR[sI + 2].y, XR[sI + 2].z, XR[sI + 2].w}; \
                unsigned ow[4]; \
                _Pragma("unroll") for (int d = 0; d < 4; ++d) { const int h = d >> 1, e0 = 2 * (d & 1); \
                    const float ua = w0[h][e0] * bflo(xp[d]) + w1[h][e0] * bflo(xc[d]) + w2[h][e0] * bflo(xn[d]) + bz[h][e0], ub = w0[h][e0 + 1] * bfhi(xp[d]) + w1[h][e0 + 1] * bfhi(xc[d]) + w2[h][e0 + 1] * bfhi(xn[d]) + bz[h][e0 + 1]; \
                    ow[d] = pk2(bflo(yw[d]) * ua, bfhi(yw[d]) * ub); } \
                *(u32x4*)(OH + (t0_ + sI) * 1024 + c0) = (u32x4){ow[0], ow[1], ow[2], ow[3]}; } } while (0)
        const int th = F.tid >> 7; u32x4 xa[10], xb[10];
        __syncthreads();
        { u32x4 wq[16];
#pragma unroll
          for (int q = 0; q < 16; ++q) { const int o = F.tid + NTHR * q, part = (o >> 3) & 7, c = (o & 7) + 8 * (o >> 6); wq[q] = *(const u32x4*)(YT + ((size_t)c * 8 + bq) * 4096 + tq0 + 8 * part); }
          FH_ISSUE(xa, 0);
#pragma unroll
          for (int q = 0; q < 16; ++q) { const int o = F.tid + NTHR * q, part = (o >> 3) & 7, c = (o & 7) + 8 * (o >> 6);
            const unsigned ww[4] = {wq[q].x, wq[q].y, wq[q].z, wq[q].w};
#pragma unroll
            for (int k = 0; k < 8; ++k) *(LAS bf16_t*)(zt + (8 * part + k) * RSZ + c * 2) = (bf16_t)((k & 1) ? (ww[k >> 1] >> 16) : (ww[k >> 1] & 0xffffu)); } }
        __syncthreads();
        FH_ISSUE(xb, 1); FH_COMP(xa, 0); FH_COMP(xb, 1);
#undef FH_ISSUE
#undef FH_COMP
      }
      __syncthreads(); }
}

__device__ void moe_offsets(const Frame& F) {
    __syncthreads();
    if (F.tid < 32) F.misc[MW_CNT + F.tid] = __hip_atomic_load(F.ctl + CW_GCOUNT + F.tid, __ATOMIC_RELAXED, __HIP_MEMORY_SCOPE_AGENT);
    __syncthreads();
    if (F.tid == 0) { unsigned rb = 0, rt = 0;
        for (int e = 0; e < 32; ++e) { const unsigned c = F.misc[MW_CNT + e]; const unsigned nt = (c + 255u) >> 8;
            F.misc[MW_ROWB + e] = rb; F.misc[MW_BASE + e] = rt; rt += nt; rb += nt * 256u; }
        F.misc[MW_ROWB + 32] = rb; F.misc[MW_RT] = rt; }
    __syncthreads();
    { LAS unsigned char* te = (LAS unsigned char*)(F.misc + MW_TILE); const unsigned rt = F.misc[MW_RT];
      for (unsigned i = F.tid; i < rt; i += NTHR) { unsigned ee = 0;
#pragma unroll
          for (unsigned e = 1; e < 32; ++e) ee = (F.misc[MW_BASE + e] <= i) ? e : ee;
          te[i] = (unsigned char)ee; } }
    __syncthreads();
}
constexpr int GT_TAB = 131072, GT_SLOT = 131072 + 17 * 1024;
__device__ void moe_gather_tables(const Frame& F, int nN) {
    LAS int* tab = (LAS int*)(F.lds + GT_TAB); LAS unsigned char* slot = F.lds + GT_SLOT; LAS int* pmof = (LAS int*)(F.lds + GT_SLOT + 544);
    const int RT = (int)F.misc[MW_RT];
    for (int i = F.tid; i < 544; i += NTHR) slot[i] = 0xFF;
    __syncthreads();
    LAS int* upm = pmof + 20;
    if (F.tid < 64) { const long Lq = (long)F.tid * F.G + F.bid; int pm = -1, pn; if (Lq < (long)RT * nN) pg8::tile_of((int)Lq, RT, nN, pm, pn); upm[F.tid] = pm; }
    __syncthreads();
    if (F.tid == 0) { int ns = 0;
        for (int i = 0; i < 64; ++i) { const int pm = upm[i]; if (pm < 0) break; if (slot[pm] == 0xFF) { const int sl = ns < 16 ? ns : 16; slot[pm] = (unsigned char)sl; pmof[sl] = pm; ++ns; } }
        F.misc[MW_Q] = (unsigned)(ns < 17 ? ns : 17); }
    __syncthreads();
    const int ns = (int)F.misc[MW_Q]; const int* LIST = (const int*)(F.ws + WS_LIST); const LAS unsigned char* te = (const LAS unsigned char*)(F.misc + MW_TILE);
    { int tv[9];
#pragma unroll
      for (int k = 0; k < 9; ++k) { const int i = F.tid + NTHR * k; tv[k] = 0;
          if (i < ns * 256) { const int sl = i >> 8, r = i & 255, pm = pmof[sl], e = te[pm];
              const int pos = pm * 256 + r - (int)F.misc[MW_ROWB + e];
              const int cnt = (int)F.misc[MW_CNT + e];
              if (pos < cnt) tv[k] = LIST[(size_t)e * T_ + pos]; } }
#pragma unroll
      for (int k = 0; k < 9; ++k) { const int i = F.tid + NTHR * k; if (i < ns * 256) tab[i] = tv[k]; } }
    __syncthreads();
}

__device__ void p12_combine(const Frame& F) {
    const unsigned char* OUTP = F.ws + WS_OUTP;                       const int* EIDX = (const int*)(F.ws + WS_EIDX); const int* POSE = (const int*)(F.ws + WS_POSE); const float* WGT = (const float*)(F.ws + WS_WGT);
    const int lane = F.lane;
    f32x4 nf[4];
#pragma unroll
    for (int q = 0; q < 4; ++q) nf[q] = *(const f32x4*)(F.in[I_NFW] + 256 * q + 4 * lane);
    const int TS = F.G * 8;
    for (int tb = F.bid * 8 + F.wave; tb < T_; tb += TS * 4) {
        int d[4][4]; float wk[4][4];
#pragma unroll
        for (int u = 0; u < 4; ++u) { const int t = tb + TS * u < T_ ? tb + TS * u : tb;
#pragma unroll
            for (int k = 0; k < 4; ++k) { d[u][k] = (int)F.misc[MW_ROWB + EIDX[t * 4 + k]] + POSE[t * 4 + k]; wk[u][k] = WGT[t * 4 + k]; } }
        u32x2 hb[4][4]; unsigned ov[4][4][4];
#pragma unroll
        for (int u = 0; u < 4; ++u) { const int t = tb + TS * u < T_ ? tb + TS * u : tb;
#pragma unroll
            for (int q = 0; q < 4; ++q) hb[u][q] = *(const u32x2*)((const bf16_t*)(F.ws + WS_H) + (size_t)t * 1024 + 256 * q + 4 * lane);
#pragma unroll
            for (int k = 0; k < 4; ++k)
#pragma unroll
                for (int q = 0; q < 4; ++q) ov[u][k][q] = *(const unsigned*)(OUTP + (size_t)d[u][k] * 1024 + 256 * q + 4 * lane); }
#pragma unroll
        for (int u = 0; u < 4; ++u) { const int t = tb + TS * u; if (t >= T_) break;
            f32x4 hv[4];
#pragma unroll
            for (int q = 0; q < 4; ++q) hv[q] = (f32x4){bflo(hb[u][q].x), bfhi(hb[u][q].x), bflo(hb[u][q].y), bfhi(hb[u][q].y)};
#pragma unroll
            for (int k = 0; k < 4; ++k) { const float w = wk[u][k];
#pragma unroll
                for (int q = 0; q < 4; ++q) { const unsigned v = ov[u][k][q];
                    const f32x2 lo = __builtin_amdgcn_cvt_pk_f32_fp8((int)v, false), hi = __builtin_amdgcn_cvt_pk_f32_fp8((int)v, true);
                    hv[q][0] += w * lo[0]; hv[q][1] += w * lo[1]; hv[q][2] += w * hi[0]; hv[q][3] += w * hi[1]; } }
            float ss = 0.f;
#pragma unroll
            for (int q = 0; q < 4; ++q) ss += hv[q][0] * hv[q][0] + hv[q][1] * hv[q][1] + hv[q][2] * hv[q][2] + hv[q][3] * hv[q][3];
            ss = wave_sum(ss); const float rstd = rsqrtf(ss * (1.f / 1024.f) + 1e-6f);
#pragma unroll
            for (int q = 0; q < 4; ++q) *(f32x4*)(F.out + (size_t)t * 1024 + 256 * q + 4 * lane) = hv[q] * rstd * nf[q]; }
    }
}

#define PHASE_FN __device__ __forceinline__ void
__device__ __forceinline__ Frame fresh(const Frame& F0) { Frame F = F0; int l; asm volatile("v_mbcnt_lo_u32_b32 %0, -1, 0\n\tv_mbcnt_hi_u32_b32 %0, -1, %0" : "=v"(l)); F.lane = l; F.tid = F0.wave * 64 + l; return F; }
PHASE_FN ph0(const Frame& F0) { const Frame F = fresh(F0);
    cvt_weights_static(F, 0, CVT_URGENT); __syncthreads();
    p0_filter(F); __syncthreads();
    norm_proj32<0>(F, F.in[I_X], F.in[I_N1W], F.in[I_WIN] + 3072, IN_TOTAL, (bf16_t*)(F.ws + WS_XN));
}
PHASE_FN ph1(const Frame& F0) { const Frame F = fresh(F0);
    using namespace pg8;
    p1_rnorm(F);
    { StaticOrder S; S.init((const bf16_t*)(F.ws + WS_XN), (const bf16_t*)(F.ws + WS_WBIN), T_, 4096, 1024, F.G, F.bid);
      EpiInProj E{(bf16_t*)(F.ws + WS_PQKV), (bf16_t*)(F.ws + WS_PR), (bf16_t*)(F.ws + WS_PHY), (bf16_t*)(F.ws + WS_X0C), 0};
      gemm_phase<EpiInProj, StaticOrder>(F.lds, S, E); }
    { StaticOrder S; S.init((const bf16_t*)(F.ws + WS_XN), (const bf16_t*)(F.ws + WS_WBIN) + (size_t)4096 * 1024, T_, 2048, 1024, F.G, F.bid);
      EpiHyT E{(bf16_t*)(F.ws + WS_PHY)};
      gemm_phase<EpiHyT, StaticOrder>(F.lds, S, E); }
}
#ifndef P2_MASK
#define P2_MASK 7
#endif
PHASE_FN ph2(const Frame& F0) { const Frame F = fresh(F0); __syncthreads();
    if (P2_MASK & 4) p2_gla_prep(F); if (PROBE_PHASE == 22) { __syncthreads(); p2_gla_prep(F); } }
PHASE_FN ph3(const Frame& F0, int rep) { const Frame F = fresh(F0); p3_gla_scan(F); __syncthreads(); if (PROBE_PHASE == 30) { p3_gla_scan(F); __syncthreads(); }
    const bool cvt_first = F0.bid >= F0.G - CVT_FIRST;
    if (cvt_first) { const Frame F2 = fresh(F0); while (cvt_batch<4>(F2, CVT_URGENT, CVT_SPLIT, F2.ctl + CW_CVTQ)) { } }
    { const Frame F1 = fresh(F0); p4_conv_mfma(F1, rep); }
    { const Frame F2 = fresh(F0); while (cvt_batch<4>(F2, CVT_URGENT, CVT_SPLIT, F2.ctl + CW_CVTQ)) { }
      while (cvt_batch<1>(F2, CVT_SPLIT, CVT_ALL, F2.ctl + CW_CVTQ + 16)) { } } }
PHASE_FN ph4(const Frame& F0) { const Frame F = fresh(F0);
    using namespace pg8;
    p5_finish(F); __syncthreads(); if (PROBE_PHASE == 40) { p5_finish(F); __syncthreads(); }
    StaticOrder S; S.init(F.ws + WS_XN8, F.ws + WS_WBIN8, T_, 2048, 1024, F.G, F.bid, 1);
    EpiGates8 E{F.ws + WS_PG};
    gemm_phase<EpiGates8, StaticOrder, true>(F.lds, S, E);
}
PHASE_FN ph5(const Frame& F0) { const Frame F = fresh(F0);
    using namespace pg8;
    DualOrder S; S.init((const bf16_t*)(F.ws + WS_OGLA), (const bf16_t*)(F.ws + WS_WBBG), (unsigned)(WS_OHY - WS_OGLA), (unsigned)(WS_WBBH - WS_WBBG), T_, 1024, 1024, F.G, F.bid);
    EpiMerge E{F.ws + WS_PG, (bf16_t*)(F.ws + WS_MERGED)};
    gemm_phase<EpiMerge, DualOrder>(F.lds, S, E);
}
PHASE_FN ph6(const Frame& F0) { const Frame F = fresh(F0);
    using namespace pg8;
    StaticOrder S; S.init((const bf16_t*)(F.ws + WS_MERGED), (const bf16_t*)(F.ws + WS_WBOUT), T_, 1024, 1024, F.G, F.bid);
    EpiResid E{F.in[I_X], (bf16_t*)(F.ws + WS_H)};
    gemm_phase<EpiResid, StaticOrder>(F.lds, S, E);
}
PHASE_FN ph7(const Frame& F0) { const Frame F = fresh(F0); norm_proj32<1>(F, (const float*)(F.ws + WS_H), F.in[I_N2W], F.in[I_RW], 32, (bf16_t*)(F.ws + WS_HN)); }
PHASE_FN ph9(const Frame& F0) { const Frame F = fresh(F0);
    using namespace pg8;
    moe_offsets(F); moe_gather_tables(F, 8);
    GatherOrder S; S.init(F.ws + WS_HN, F.ws + WS_WBGU, (const LAS unsigned char*)(F.misc + MW_TILE), (const LAS unsigned char*)(F.lds + GT_SLOT), (const LAS int*)(F.lds + GT_TAB),
                          (int)F.misc[MW_RT], 2048, 1024, 1, F.G, F.bid);
    EpiGateUp E{F.in[I_BGU], F.ws + WS_ACT};
    gemm_phase<EpiGateUp, GatherOrder, true>(F.lds, S, E);
}
PHASE_FN ph10(const Frame& F0) { const Frame F = fresh(F0);
    using namespace pg8;
#if MK_N_LAUNCHES != 1
    moe_offsets(F);
#endif
    GroupedOrder S; S.init(F.ws + WS_ACT, F.ws + WS_WBDN, (const LAS unsigned char*)(F.misc + MW_TILE), (int)F.misc[MW_RT], 1024, 1024, 1, F.G, F.bid);
    EpiDown E{F.in[I_BDN], F.ws + WS_OUTP};
    gemm_phase<EpiDown, GroupedOrder, true>(F.lds, S, E);
}
PHASE_FN ph11(const Frame& F0) { const Frame F = fresh(F0);
#if MK_N_LAUNCHES != 1
    moe_offsets(F);
#endif
    __syncthreads(); p12_combine(F); }

constexpr int N_PHASES = 12;
__global__ void __launch_bounds__(NTHR, 2) hybrid_fwd(Params P) {
    extern __shared__ __attribute__((aligned(16))) unsigned char lds_raw[];
    Frame F;
    F.lds = (LAS unsigned char*)lds_raw; F.misc = (LAS unsigned*)(F.lds + MISC_OFF);
    F.tid = threadIdx.x; F.lane = F.tid & 63; F.wave = __builtin_amdgcn_readfirstlane(F.tid >> 6); F.bid = blockIdx.x; F.G = gridDim.x;
    F.in = P.in; F.out = P.out; F.ws = P.ws; F.ctl = (unsigned*)(P.ws + WS_CTL);
    if (F.tid < 4) F.misc[F.tid] = 0u;
    __syncthreads();
    XcdBarrier bar; bar.bar = F.ctl + CW_BAR; bar.x = 0; bar.st = nullptr;
    const int lo = P.ph_lo, hi = P.ph_hi;
    if (hi - lo > 1) bar = xcd_barrier_post(F.ctl + CW_BAR, (volatile LAS unsigned*)F.misc);
#ifndef ONLY_PHASE
#define ONLY_PHASE -1
#endif
#define IN(k) (lo <= (k) && (k) < hi && (ONLY_PHASE < 0 || ONLY_PHASE == (k)))
#define SEAM(k) do { if (IN(k) && IN((k) + 1)) xcd_barrier(bar); else __syncthreads(); } while (0)

    if (IN(0)) { ph0(F); if (PROBE_PHASE == 0) ph0(F); }
    SEAM(0);
    if (IN(1)) { ph1(F); if (PROBE_PHASE == 1) ph1(F); }
    SEAM(1);
    if (IN(2)) { ph2(F); if (PROBE_PHASE == 2) ph2(F); }
    SEAM(2);
    if (IN(3)) { ph3(F, 0); if (PROBE_PHASE == 3) ph3(F, 1); }
    SEAM(3);
    if (IN(4)) { ph4(F); if (PROBE_PHASE == 4) ph4(F); }
    SEAM(4);
    if (IN(5)) { ph5(F); if (PROBE_PHASE == 5) ph5(F); }
    SEAM(5);
    if (IN(6)) { ph6(F); if (PROBE_PHASE == 6) ph6(F); }
    SEAM(6);
    if (IN(7)) ph7(F);
    if (IN(7) && IN(9)) xcd_barrier(bar); else __syncthreads();
    if (IN(9)) { ph9(F); if (PROBE_PHASE == 9) ph9(F); }
    SEAM(9);
    if (IN(10)) { ph10(F); if (PROBE_PHASE == 10) ph10(F); }
    SEAM(10);
    if (IN(11)) { ph11(F); if (PROBE_PHASE == 11) ph11(F); }
#undef IN
#undef SEAM
}

extern "C" void kernel_launch(void* const* d_in, const int* in_sizes, int n_in, void* d_out, int out_size, void* d_ws, size_t ws_size, hipStream_t stream) {
    static int grid = 0;
    if (grid == 0) {
        if (n_in != 27 || out_size != T_ * D_ || ws_size < WS_END) { fprintf(stderr, "kernel_launch: unexpected shapes (n_in %d out %d ws %zu need %zu)\n", n_in, out_size, ws_size, (size_t)WS_END); grid = -1; return; }
        int dev = 0, cus = 0, per_cu = 0;
        if (hipGetDevice(&dev) != hipSuccess || hipDeviceGetAttribute(&cus, hipDeviceAttributeMultiprocessorCount, dev) != hipSuccess) { grid = -1; return; }
        if (hipFuncSetAttribute((const void*)hybrid_fwd, hipFuncAttributeMaxDynamicSharedMemorySize, LDS_BYTES) != hipSuccess) { fprintf(stderr, "kernel_launch: hipFuncSetAttribute failed\n"); grid = -1; return; }
        if (hipOccupancyMaxActiveBlocksPerMultiprocessor(&per_cu, (const void*)hybrid_fwd, NTHR, LDS_BYTES) != hipSuccess || per_cu < 1) { fprintf(stderr, "kernel_launch: occupancy query says %d\n", per_cu); (void)hipGetLastError(); }
        grid = cus;
        if (grid != 256) { fprintf(stderr, "kernel_launch: built for a 256-CU device, found %d CUs\n", cus); grid = -1; return; }
    }
    if (grid < 0) return;
    hipMemsetAsync((char*)d_ws + WS_CTL, 0, CTL_BYTES, stream);
    Params p{};
    for (int i = 0; i < 27; ++i) p.in[i] = (const float*)d_in[i];
    p.out = (float*)d_out; p.ws = (unsigned char*)d_ws;
#if MK_N_LAUNCHES == 1
    p.ph_lo = 0; p.ph_hi = N_PHASES;
    hipLaunchKernelGGL(hybrid_fwd, dim3(grid), dim3(NTHR), LDS_BYTES, stream, p);
#else
    for (int k = 0; k < 12; ++k) { p.ph_lo = k; p.ph_hi = k + 1; hipLaunchKernelGGL(hybrid_fwd, dim3(grid), dim3(NTHR), LDS_BYTES, stream, p); }
#endif
}
```
